# Optimizing an MI355X kernel written in HIP

```python
import math
import jax, jax.numpy as jnp
from jax import lax
import numpy as np

D_MODEL = 2048
BATCH = 16
SEQ = 2048
DEPTH = 2

CTX_LEN = 256
GRID_W = 64

ALPHA = (2 * DEPTH) ** 0.25
BETA = (8 * DEPTH) ** -0.25
LN_EPS = 1e-5

D_MIX = D_MODEL
SSD_WIDTH = D_MIX // 2
SSD_HEADDIM = 64
SSD_HEADS = SSD_WIDTH // SSD_HEADDIM
SSD_GROUPS = 2
SSD_HPG = SSD_HEADS // SSD_GROUPS
SSD_STATE = 128
SSD_CONV = 3
SSD_CHUNK = 128
SSD_CONV_DIM = SSD_WIDTH + 2 * SSD_GROUPS * SSD_STATE
FNET_WIDTH = D_MIX - SSD_WIDTH
FNET_GROUPS = 4
FNET_GW = FNET_WIDTH // FNET_GROUPS
IN_PROJ_A = SSD_WIDTH + SSD_CONV_DIM + 2 * SSD_HEADS + FNET_WIDTH

RWKV_HEADSIZE = 64
RWKV_HEADS = D_MODEL // RWKV_HEADSIZE
DECAY_LORA = 96
AAA_LORA = 96
GATE_LORA = 256
GN_EPS = 64e-5

N_EXPERTS = 32
N_GROUPS = 4
EXPERTS_PER_GROUP = N_EXPERTS // N_GROUPS
TOP_K = 2
D_EXPERT = 512
MOE_BLOCK = 128

N_EVEN = (DEPTH + 1) // 2
N_ODD = DEPTH // 2

kernel_name = "ssd_fnet_rwkv7_grouped_moe_deepnorm_prefix"


def layer_norm(x, g, b):
    xf = x.astype(jnp.float32)
    mu = jnp.mean(xf, -1, keepdims=True)
    var = jnp.mean(jnp.square(xf - mu), -1, keepdims=True)
    return ((xf - mu) * lax.rsqrt(var + LN_EPS) * g + b).astype(x.dtype)


def dwconv_centred(x, w, b):
    K, C = w.shape
    y = lax.conv_general_dilated(x, w[:, None, :].astype(x.dtype), window_strides=(1,),
                                 padding=[(K // 2, K // 2)],
                                 dimension_numbers=("NWC", "WIO", "NWC"),
                                 feature_group_count=C)
    return y + b


def ssd_chunked(xh, dt, dA, Bm, Cm, s0):
    b, L, g, r, p = xh.shape
    n = Bm.shape[-1]
    Q = SSD_CHUNK
    nc = L // Q
    x = xh.reshape(b, nc, Q, g, r, p)
    dtc = dt.reshape(b, nc, Q, g, r)
    Bc = Bm.reshape(b, nc, Q, g, n)
    Cc = Cm.reshape(b, nc, Q, g, n)
    a_cum = jnp.cumsum(dA.astype(jnp.float32).reshape(b, nc, Q, g, r), axis=2)
    a_t = jnp.moveaxis(a_cum, 2, -1)
    seg = a_t[..., :, None] - a_t[..., None, :]
    causal = jnp.tril(jnp.ones((Q, Q), bool))
    decay = jnp.exp(jnp.where(causal, seg, -jnp.inf))
    scores = jnp.einsum("bclgn,bcsgn->bcgls", Cc, Bc)
    xdt = x * dtc[..., None]
    y_diag = jnp.einsum("bcgrls,bcsgrp->bclgrp", scores[:, :, :, None] * decay, xdt)
    decay_to_end = jnp.exp(a_cum[:, :, -1:] - a_cum)
    states = jnp.einsum("bcsgn,bcsgrp->bcgrpn", Bc, xdt * decay_to_end[..., None])
    chunk_decay = jnp.exp(a_cum[:, :, -1])

    def step(s, inp):
        st, cd = inp
        return s * cd[..., None, None] + st, s

    s_fin, s_in = lax.scan(step, s0, (jnp.moveaxis(states, 1, 0), jnp.moveaxis(chunk_decay, 1, 0)))
    s_in = jnp.moveaxis(s_in, 0, 1)
    y_off = jnp.einsum("bclgn,bcgrpn->bclgrp", Cc, s_in) * jnp.exp(a_cum)[..., None]
    return (y_diag + y_off).reshape(b, L, g, r, p), s_fin


def fourier_mix(f):
    b, L, _ = f.shape
    fg = f.astype(jnp.float32).reshape(b, L, FNET_GROUPS, FNET_GW)
    out = jnp.fft.fft2(fg, axes=(1, 3), norm="ortho").real
    return out.reshape(b, L, FNET_WIDTH).astype(f.dtype)


def even_mixer(h_lat, h_ctx, w_in, conv_w, conv_b, a_log, dt_bias, d_skip, norm_w, w_out, need_ctx):
    A = -jnp.exp(a_log.astype(jnp.float32))

    def split_inputs(h):
        b, L, _ = h.shape
        pr = h @ w_in
        o1 = SSD_WIDTH
        o2 = o1 + SSD_CONV_DIM
        o3 = o2 + 2 * SSD_HEADS
        z, xbc, dtr, f = pr[..., :o1], pr[..., o1:o2], pr[..., o2:o3], pr[..., o3:]
        xbc = jax.nn.silu(dwconv_centred(xbc, conv_w, conv_b))
        gn = SSD_GROUPS * SSD_STATE
        xs = xbc[..., :SSD_WIDTH].reshape(b, L, SSD_GROUPS, SSD_HPG, SSD_HEADDIM)
        Bm = xbc[..., SSD_WIDTH:SSD_WIDTH + gn].reshape(b, L, SSD_GROUPS, SSD_STATE)
        Cm = xbc[..., SSD_WIDTH + gn:].reshape(b, L, SSD_GROUPS, SSD_STATE)
        dt = jax.nn.softplus(dtr.astype(jnp.float32).reshape(b, L, 2, SSD_HEADS) + dt_bias)
        return z, xs, Bm, Cm, dt, f

    def scan_both(xs, Bm, Cm, dt, s0):
        b, L = xs.shape[:2]
        flip = lambda t: jnp.flip(t, axis=1)
        x2 = jnp.concatenate([xs, flip(xs)], 0)
        B2 = jnp.concatenate([Bm, flip(Bm)], 0)
        C2 = jnp.concatenate([Cm, flip(Cm)], 0)
        dt2 = jnp.concatenate([dt[:, :, 0], flip(dt[:, :, 1])], 0)
        dA2 = dt2 * jnp.repeat(A, b, axis=0)[:, None, :]
        shp = (2 * b, L, SSD_GROUPS, SSD_HPG)
        y2, s_fin = ssd_chunked(x2, dt2.reshape(shp), dA2.reshape(shp), B2, C2, s0)
        return y2[:b] + flip(y2[b:]), s_fin

    def ssd_out(y, xs, z):
        b, L = y.shape[:2]
        y = y + d_skip.reshape(SSD_GROUPS, SSD_HPG)[..., None] * xs
        u = (y.reshape(b, L, SSD_WIDTH) * jax.nn.silu(z.astype(jnp.float32))).reshape(b, L, SSD_GROUPS, -1)
        u = u * lax.rsqrt(jnp.mean(jnp.square(u), -1, keepdims=True) + LN_EPS)
        return (u.reshape(b, L, SSD_WIDTH) * norm_w).astype(z.dtype)

    bsz = h_ctx.shape[0]
    s0 = jnp.zeros((2 * bsz, SSD_GROUPS, SSD_HPG, SSD_HEADDIM, SSD_STATE), jnp.float32)
    zc, xc, Bc, Cc, dtc, fc = split_inputs(h_ctx)
    yc, s_ctx = scan_both(xc, Bc, Cc, dtc, s0)
    zl, xl, Bl, Cl, dtl, fl = split_inputs(h_lat)
    yl, _ = scan_both(xl, Bl, Cl, dtl, s_ctx)
    y_lat = jnp.concatenate([ssd_out(yl, xl, zl), fourier_mix(fl)], -1) @ w_out
    y_ctx = None
    if need_ctx:
        y_ctx = jnp.concatenate([ssd_out(yc, xc, zc), fourier_mix(fc)], -1) @ w_out
    return y_lat, y_ctx


def grid_shift(x):
    b, L, D = x.shape
    rows = L // GRID_W
    q = D // 4
    xg = x.reshape(b, rows, GRID_W, D)
    left = jnp.pad(xg[:, :, :-1, :q], ((0, 0), (0, 0), (1, 0), (0, 0)))
    right = jnp.pad(xg[:, :, 1:, q:2 * q], ((0, 0), (0, 0), (0, 1), (0, 0)))
    up = jnp.pad(xg[:, :-1, :, 2 * q:3 * q], ((0, 0), (1, 0), (0, 0), (0, 0)))
    down = jnp.pad(xg[:, 1:, :, 3 * q:], ((0, 0), (0, 1), (0, 0), (0, 0)))
    return jnp.concatenate([left, right, up, down], -1).reshape(b, L, D)


def seq_shift(x):
    D = x.shape[-1]
    q = D // 4
    prev = jnp.pad(x[:, :-1], ((0, 0), (1, 0), (0, 0)))
    nxt = jnp.pad(x[:, 1:], ((0, 0), (0, 1), (0, 0)))
    return jnp.concatenate([prev[..., :q], nxt[..., q:2 * q], prev[..., 2 * q:3 * q], nxt[..., 3 * q:]], -1)


def rwkv_inputs(h, shifted, mu, w_rkv, w0, w1, w2, a0, a1, a2, g1, g2, k_k, k_a):
    f32 = jnp.float32
    heads = lambda t: t.reshape(t.shape[:-1] + (RWKV_HEADS, RWKV_HEADSIZE))
    xx = shifted - h
    xr, xw, xk, xv, xa, xg = (h + xx * mu[i] for i in range(6))
    r = xr @ w_rkv[0]
    k = xk @ w_rkv[1]
    v = xv @ w_rkv[2]
    dw = jnp.einsum("eblr,erd->ebld", jnp.tanh(jnp.einsum("bld,edr->eblr", xw, w1)), w2)
    w_log = -jax.nn.softplus(-(w0[:, None, None, :] + dw).astype(f32)) - 0.5
    decay = jnp.exp(-jnp.exp(w_log))
    a = jax.nn.sigmoid((a0[:, None, None, :]
                        + jnp.einsum("eblr,erd->ebld", jnp.einsum("bld,edr->eblr", xa, a1), a2)).astype(f32))
    g = jax.nn.sigmoid(xg @ g1) @ g2
    kk = heads((k * k_k).astype(f32))
    kk = kk / jnp.maximum(jnp.sqrt(jnp.sum(jnp.square(kk), -1, keepdims=True)), 1e-12)
    k_dir = k.astype(f32)[None] * (1.0 + (a - 1.0) * k_a)
    return (heads(r.astype(f32)), kk, heads(v.astype(f32)), heads(decay), heads(k_dir), heads(a),
            heads(k.astype(f32)), g)


def wkv_bidir(r, kk, v, w, k, a, s0):
    L = r.shape[1]

    def take(arr, t):
        return lax.dynamic_index_in_dim(arr, t, axis=1, keepdims=False)

    def step(S, t):
        tb = L - 1 - t
        r_t = jnp.stack([take(r, t), take(r, tb)])
        kk_t = jnp.stack([take(kk, t), take(kk, tb)])
        v_t = jnp.stack([take(v, t), take(v, tb)])
        w_t = jnp.stack([take(w[0], t), take(w[1], tb)])
        k_t = jnp.stack([take(k[0], t), take(k[1], tb)])
        a_t = jnp.stack([take(a[0], t), take(a[1], tb)])
        sa = jnp.einsum("ebhvk,ebhk->ebhv", S, kk_t)
        S = (S * w_t[..., None, :] - sa[..., None] * (kk_t * a_t)[..., None, :]
             + v_t[..., :, None] * k_t[..., None, :])
        return S, jnp.einsum("ebhvk,ebhk->ebhv", S, r_t)

    S_fin, ys = lax.scan(step, s0, jnp.arange(L))
    y = ys[:, 0] + ys[::-1, 1]
    return jnp.moveaxis(y, 0, 1), S_fin


def rwkv_readout(y, r, k, v, g, r_k, lnx_w, lnx_b, w_o, dtype):
    b, L = y.shape[:2]
    mu = jnp.mean(y, -1, keepdims=True)
    var = jnp.mean(jnp.square(y - mu), -1, keepdims=True)
    yn = ((y - mu) * lax.rsqrt(var + GN_EPS)).reshape(b, L, D_MODEL) * lnx_w + lnx_b
    bonus = (jnp.sum(r * k * r_k, -1, keepdims=True) * v).reshape(b, L, D_MODEL)
    return ((yn + bonus) * g).astype(dtype) @ w_o


def odd_mixer(h_lat, h_ctx, mu, w_rkv, w_o, w0, w1, w2, a0, a1, a2, g1, g2, k_k, k_a, r_k,
              lnx_w, lnx_b, need_ctx):
    def inputs(h, shifted):
        return rwkv_inputs(h, shifted, mu, w_rkv, w0, w1, w2, a0, a1, a2, g1, g2, k_k, k_a)

    bsz = h_ctx.shape[0]
    s0 = jnp.zeros((2, bsz, RWKV_HEADS, RWKV_HEADSIZE, RWKV_HEADSIZE), jnp.float32)
    rc, kkc, vc, wc, kdc, ac, kc, gc = inputs(h_ctx, seq_shift(h_ctx))
    yc, s_ctx = wkv_bidir(rc, kkc, vc, wc, kdc, ac, s0)
    rl, kkl, vl, wl, kdl, al, kl, gl = inputs(h_lat, grid_shift(h_lat))
    yl, _ = wkv_bidir(rl, kkl, vl, wl, kdl, al, s_ctx)
    y_lat = rwkv_readout(yl, rl, kl, vl, gl, r_k, lnx_w, lnx_b, w_o, h_lat.dtype)
    y_ctx = None
    if need_ctx:
        y_ctx = rwkv_readout(yc, rc, kc, vc, gc, r_k, lnx_w, lnx_b, w_o, h_ctx.dtype)
    return y_lat, y_ctx


def moe(h, router_w, router_bias, w_gate, w_up, w_down):
    T, D = h.shape
    s = jax.nn.sigmoid((h @ router_w).astype(jnp.float32))
    s_sel = s + router_bias
    group_score = lax.top_k(s_sel.reshape(T, N_GROUPS, EXPERTS_PER_GROUP), 2)[0].sum(-1)
    gsel = jnp.argmax(group_score, -1)
    in_group = (jnp.arange(N_EXPERTS) // EXPERTS_PER_GROUP)[None, :] == gsel[:, None]
    _, idx = lax.top_k(jnp.where(in_group, s_sel, -jnp.inf), TOP_K)
    wts = jnp.take_along_axis(s, idx, -1)
    wts = wts / jnp.sum(wts, -1, keepdims=True)

    A = T * TOP_K
    e_flat = idx.reshape(A)
    tok = jnp.repeat(jnp.arange(T), TOP_K)
    order = jnp.argsort(e_flat)
    e_s, tok_s, g_s = e_flat[order], tok[order], wts.reshape(A)[order]
    counts = jnp.bincount(e_flat, length=N_EXPERTS)
    padded = (counts + MOE_BLOCK - 1) // MOE_BLOCK * MOE_BLOCK
    start = jnp.cumsum(counts) - counts
    ends = jnp.cumsum(padded)
    pstart = ends - padded
    dest = pstart[e_s] + jnp.arange(A) - start[e_s]
    n_blocks = -(-(A + N_EXPERTS * (MOE_BLOCK - 1)) // MOE_BLOCK)
    P = n_blocks * MOE_BLOCK
    xbuf = jnp.zeros((P, D), h.dtype).at[dest].set(h[tok_s])
    block_e = jnp.minimum(jnp.searchsorted(ends, jnp.arange(n_blocks) * MOE_BLOCK, side="right"),
                          N_EXPERTS - 1)

    def expert_block(args):
        xb, e = args
        hid = jax.nn.silu(xb @ w_gate[e]) * (xb @ w_up[e])
        return hid @ w_down[e]

    ybuf = lax.map(expert_block, (xbuf.reshape(n_blocks, MOE_BLOCK, D), block_e)).reshape(P, D)
    y_s = ybuf[dest] * g_s[:, None].astype(h.dtype)
    return jnp.zeros((T, D), h.dtype).at[tok_s].add(y_s)


def setup_inputs(seed: int = 0) -> dict:
    key = jax.random.key(seed)
    ks = iter(jax.random.split(key, 64))
    f32 = jnp.float32
    D = D_MODEL

    def nrm(shape, scale):
        return jax.random.normal(next(ks), shape, f32) * scale

    def near_one(shape):
        return 1.0 + nrm(shape, 0.02)

    def unif(shape, lo, hi):
        return jax.random.uniform(next(ks), shape, f32, lo, hi)

    x = nrm((BATCH, SEQ, D), 1.0)
    c = nrm((BATCH, D), 1.0)
    ctx = nrm((BATCH, CTX_LEN, D), 1.0)
    c_ctx = nrm((D,), 1.0)
    w_mod = nrm((DEPTH, D, 6 * D), D ** -0.5)
    b_mod = nrm((DEPTH, 6 * D), 0.02)
    ln_g = near_one((DEPTH, 2, D))
    ln_b = nrm((DEPTH, 2, D), 0.02)

    ssd_w_in = nrm((N_EVEN, D, IN_PROJ_A), D ** -0.5)
    ssd_conv_w = nrm((N_EVEN, SSD_CONV, SSD_CONV_DIM), SSD_CONV ** -0.5)
    ssd_conv_b = nrm((N_EVEN, SSD_CONV_DIM), 0.02)
    ssd_a_log = jnp.log(unif((N_EVEN, 2, SSD_HEADS), 1.0, 16.0))
    dt0 = jnp.exp(unif((N_EVEN, 2, SSD_HEADS), math.log(1e-3), math.log(1e-1)))
    ssd_dt_bias = dt0 + jnp.log(-jnp.expm1(-dt0))
    ssd_d = near_one((N_EVEN, SSD_HEADS))
    ssd_norm_w = near_one((N_EVEN, SSD_WIDTH))
    even_w_out = nrm((N_EVEN, D_MIX, D), D_MIX ** -0.5 * BETA)

    rwkv_mu = unif((N_ODD, 6, D), 0.0, 1.0)
    rwkv_w_rkv = nrm((N_ODD, 3, D, D), D ** -0.5)
    rwkv_w_o = nrm((N_ODD, D, D), D ** -0.5 * BETA)
    rwkv_w0 = unif((N_ODD, 2, D), -6.0, -1.0)
    rwkv_w1 = nrm((N_ODD, 2, D, DECAY_LORA), D ** -0.5)
    rwkv_w2 = nrm((N_ODD, 2, DECAY_LORA, D), 0.1 * DECAY_LORA ** -0.5)
    rwkv_a0 = nrm((N_ODD, 2, D), 0.1)
    rwkv_a1 = nrm((N_ODD, 2, D, AAA_LORA), D ** -0.5)
    rwkv_a2 = nrm((N_ODD, 2, AAA_LORA, D), 0.1 * AAA_LORA ** -0.5)
    rwkv_g1 = nrm((N_ODD, D, GATE_LORA), D ** -0.5)
    rwkv_g2 = nrm((N_ODD, GATE_LORA, D), GATE_LORA ** -0.5)
    rwkv_k_k = 0.85 + nrm((N_ODD, D), 0.02)
    rwkv_k_a = near_one((N_ODD, D))
    rwkv_r_k = nrm((N_ODD, RWKV_HEADS, RWKV_HEADSIZE), 0.1)
    rwkv_lnx_w = near_one((N_ODD, D))
    rwkv_lnx_b = nrm((N_ODD, D), 0.02)

    router_w = nrm((D, N_EXPERTS), D ** -0.5)
    router_bias = nrm((N_EXPERTS,), 0.01)
    moe_w_gate = nrm((DEPTH, N_EXPERTS, D, D_EXPERT), D ** -0.5)
    moe_w_up = nrm((DEPTH, N_EXPERTS, D, D_EXPERT), D ** -0.5)
    moe_w_down = nrm((DEPTH, N_EXPERTS, D_EXPERT, D), D_EXPERT ** -0.5 * BETA)
    return {"x": x, "c": c, "ctx": ctx, "c_ctx": c_ctx, "w_mod": w_mod, "b_mod": b_mod,
            "ln_g": ln_g, "ln_b": ln_b, "ssd_w_in": ssd_w_in, "ssd_conv_w": ssd_conv_w,
            "ssd_conv_b": ssd_conv_b, "ssd_a_log": ssd_a_log, "ssd_dt_bias": ssd_dt_bias, "ssd_d": ssd_d,
            "ssd_norm_w": ssd_norm_w, "even_w_out": even_w_out, "rwkv_mu": rwkv_mu,
            "rwkv_w_rkv": rwkv_w_rkv, "rwkv_w_o": rwkv_w_o, "rwkv_w0": rwkv_w0, "rwkv_w1": rwkv_w1,
            "rwkv_w2": rwkv_w2, "rwkv_a0": rwkv_a0, "rwkv_a1": rwkv_a1, "rwkv_a2": rwkv_a2,
            "rwkv_g1": rwkv_g1, "rwkv_g2": rwkv_g2, "rwkv_k_k": rwkv_k_k, "rwkv_k_a": rwkv_k_a,
            "rwkv_r_k": rwkv_r_k, "rwkv_lnx_w": rwkv_lnx_w, "rwkv_lnx_b": rwkv_lnx_b,
            "router_w": router_w, "router_bias": router_bias, "moe_w_gate": moe_w_gate,
            "moe_w_up": moe_w_up, "moe_w_down": moe_w_down}


def reference(x, c, ctx, c_ctx, w_mod, b_mod, ln_g, ln_b, ssd_w_in, ssd_conv_w, ssd_conv_b, ssd_a_log,
              ssd_dt_bias, ssd_d, ssd_norm_w, even_w_out, rwkv_mu, rwkv_w_rkv, rwkv_w_o, rwkv_w0, rwkv_w1,
              rwkv_w2, rwkv_a0, rwkv_a1, rwkv_a2, rwkv_g1, rwkv_g2, rwkv_k_k, rwkv_k_a, rwkv_r_k,
              rwkv_lnx_w, rwkv_lnx_b, router_w, router_bias, moe_w_gate, moe_w_up, moe_w_down):
    x_lat, x_ctx = x, ctx
    for i in range(DEPTH):
        last = i == DEPTH - 1
        j = i // 2
        ml = [m[:, None, :] for m in jnp.split(jax.nn.silu(c) @ w_mod[i] + b_mod[i], 6, axis=-1)]
        mc = jnp.split(jax.nn.silu(c_ctx) @ w_mod[i] + b_mod[i], 6, axis=-1)
        h_lat = x_lat * (1 + ml[1]) + ml[0]
        h_ctx = x_ctx * (1 + mc[1]) + mc[0]
        if i % 2 == 0:
            y_lat, y_ctx = even_mixer(h_lat, h_ctx, ssd_w_in[j], ssd_conv_w[j], ssd_conv_b[j], ssd_a_log[j],
                                      ssd_dt_bias[j], ssd_d[j], ssd_norm_w[j], even_w_out[j], not last)
        else:
            y_lat, y_ctx = odd_mixer(h_lat, h_ctx, rwkv_mu[j], rwkv_w_rkv[j], rwkv_w_o[j], rwkv_w0[j],
                                     rwkv_w1[j], rwkv_w2[j], rwkv_a0[j], rwkv_a1[j], rwkv_a2[j], rwkv_g1[j],
                                     rwkv_g2[j], rwkv_k_k[j], rwkv_k_a[j], rwkv_r_k[j], rwkv_lnx_w[j],
                                     rwkv_lnx_b[j], not last)
        x_lat = layer_norm(ALPHA * x_lat + ml[2] * y_lat, ln_g[i, 0], ln_b[i, 0])
        h2_lat = x_lat * (1 + ml[4]) + ml[3]
        if last:
            y2_lat = moe(h2_lat.reshape(-1, D_MODEL), router_w, router_bias, moe_w_gate[i], moe_w_up[i],
                         moe_w_down[i]).reshape(x_lat.shape)
        else:
            x_ctx = layer_norm(ALPHA * x_ctx + mc[2] * y_ctx, ln_g[i, 0], ln_b[i, 0])
            h2_ctx = x_ctx * (1 + mc[4]) + mc[3]
            n_lat = h2_lat.shape[0] * h2_lat.shape[1]
            tokens = jnp.concatenate([h2_lat.reshape(-1, D_MODEL), h2_ctx.reshape(-1, D_MODEL)], 0)
            y2 = moe(tokens, router_w, router_bias, moe_w_gate[i], moe_w_up[i], moe_w_down[i])
            y2_lat = y2[:n_lat].reshape(x_lat.shape)
            x_ctx = layer_norm(ALPHA * x_ctx + mc[5] * y2[n_lat:].reshape(x_ctx.shape), ln_g[i, 1], ln_b[i, 1])
        x_lat = layer_norm(ALPHA * x_lat + ml[5] * y2_lat, ln_g[i, 1], ln_b[i, 1])
    return x_lat
```

```cpp
#include <hip/hip_runtime.h>
#include <cstdio>
#include <cstdint>
#include <cstddef>

#define LAS __attribute__((address_space(3)))
typedef unsigned short bf16_t;
typedef short bf16x8 __attribute__((ext_vector_type(8)));
typedef float f32x4 __attribute__((ext_vector_type(4)));
typedef unsigned u32x4 __attribute__((ext_vector_type(4)));
typedef unsigned u32x2 __attribute__((ext_vector_type(2)));

constexpr int D = 2048, NB = 16, SEQ = 2048, CTXL = 256;
constexpr int TL = NB * SEQ;
constexpr int TCX = NB * CTXL;
constexpr int T = TL + TCX;
constexpr int NPROJ = 3616, NPROJ_PAD = 3840;
constexpr int NE = 32;
constexpr float ALPHA = 1.41421356237f;
constexpr float LN_EPS = 1e-5f, GN_EPS = 64e-5f;
constexpr int NWAVES = 8, NTHREADS = 512;

constexpr size_t MiB = (size_t)1 << 20;
constexpr size_t WS_CTL = 0;
constexpr size_t CTL_BYTES = 65536;
constexpr size_t WS_MOD = 1 * MiB;
constexpr size_t WS_DT = 3 * MiB;
constexpr size_t WS_LOGIT = 8 * MiB;
constexpr size_t WS_ROUTE = 13 * MiB;
constexpr size_t WS_TOK = 13 * MiB + 640 * 1024;
constexpr size_t WS_INVN = 14 * MiB;
constexpr size_t WS_TW = 19 * MiB;
constexpr size_t WS_TA = 37 * MiB;
constexpr size_t WS_TG = 55 * MiB;
constexpr size_t WS_WIN = 73 * MiB;
constexpr size_t WS_WOUT = 88 * MiB;
constexpr size_t WS_BT1 = 96 * MiB;
constexpr size_t WS_BT2W = 123 * MiB;
constexpr size_t WS_BT2A = 125 * MiB;
constexpr size_t WS_G2T = 127 * MiB;
constexpr size_t WS_WOT = 128 * MiB;
constexpr size_t WS_ROUT = 136 * MiB;
constexpr size_t WS_TW1 = 137 * MiB;
constexpr size_t WS_TW2L = 138 * MiB;
constexpr size_t WS_TW2C = 154 * MiB;
constexpr size_t WS_MOE = 155 * MiB;
constexpr size_t WS_SLOT0 = 347 * MiB;
constexpr size_t SLOT = 144 * MiB;
constexpr size_t WS_END = WS_SLOT0 + 7 * SLOT;
#define WSLOT(i) (WS_SLOT0 + (size_t)(i) * SLOT)
constexpr int CW_BAR = 0;
constexpr int CW_CNT0 = 4096;
constexpr int CW_CNT1 = 4160;
constexpr int CW_RB = 8192;
constexpr size_t WS_ROUTB = 14 * MiB;
constexpr int CW_CVQ0 = 4224;
constexpr float F8_WSCALE = 64.f, F8_WINV = 1.f / 64.f;
constexpr size_t MOE_E_ELEMS = (size_t)1024 * 2048 + (size_t)2048 * 512;
constexpr int MOE_P0 = 81920;
constexpr int MOE_P1 = 73728;

constexpr int LDS_RING = 131072;
constexpr int LDS_MISC = 162816;
constexpr int LDS_BYTES = LDS_MISC + 1024;

__device__ __forceinline__ float bf2f(unsigned v16) { return __uint_as_float(v16 << 16); }
__device__ __forceinline__ float bflo(unsigned u) { return __uint_as_float(u << 16); }
__device__ __forceinline__ float bfhi(unsigned u) { return __uint_as_float(u & 0xffff0000u); }
typedef __bf16 bf16x2n_t __attribute__((ext_vector_type(2)));
typedef float f32x2n_t __attribute__((ext_vector_type(2)));
__device__ __forceinline__ unsigned pk2(float lo, float hi) { const f32x2n_t v = {lo, hi}; return __builtin_bit_cast(unsigned, __builtin_convertvector(v, bf16x2n_t)); }
__device__ __forceinline__ void unpack8(const u32x4 u, float (&f)[8]) {
    f[0] = bflo(u.x); f[1] = bfhi(u.x); f[2] = bflo(u.y); f[3] = bfhi(u.y); f[4] = bflo(u.z); f[5] = bfhi(u.z); f[6] = bflo(u.w); f[7] = bfhi(u.w);
}
__device__ __forceinline__ u32x4 pack8(const float (&f)[8]) { u32x4 o; o.x = pk2(f[0], f[1]); o.y = pk2(f[2], f[3]); o.z = pk2(f[4], f[5]); o.w = pk2(f[6], f[7]); return o; }
#define NTL(p) __builtin_nontemporal_load(p)
#define NTS(v, p) __builtin_nontemporal_store((v), (p))
__device__ __forceinline__ unsigned pk4_f8(float a, float b, float c, float d) { int p = 0; p = __builtin_amdgcn_cvt_pk_fp8_f32(a, b, p, false); p = __builtin_amdgcn_cvt_pk_fp8_f32(c, d, p, true); return (unsigned)p; }
typedef float f32x2_t __attribute__((ext_vector_type(2)));
__device__ __forceinline__ void unpack8_f8(const u32x2 u, float* f) {
    const f32x2_t a = __builtin_amdgcn_cvt_pk_f32_fp8((int)u.x, false), b = __builtin_amdgcn_cvt_pk_f32_fp8((int)u.x, true), c = __builtin_amdgcn_cvt_pk_f32_fp8((int)u.y, false), d = __builtin_amdgcn_cvt_pk_f32_fp8((int)u.y, true);
    f[0] = a.x; f[1] = a.y; f[2] = b.x; f[3] = b.y; f[4] = c.x; f[5] = c.y; f[6] = d.x; f[7] = d.y;
}
__device__ __forceinline__ float sigmoidf_(float x) { return __builtin_amdgcn_rcpf(1.f + __expf(-x)); }
__device__ __forceinline__ float siluf_(float x) { return x * __builtin_amdgcn_rcpf(1.f + __expf(-x)); }
__device__ __forceinline__ float softplusf_(float x) { return fmaxf(x, 0.f) + log1pf(__expf(-fabsf(x))); }
__device__ __forceinline__ float wave_sum(float v) {
#pragma unroll
    for (int o = 1; o < 64; o <<= 1) v += __shfl_xor(v, o);
    return v;
}
__device__ __forceinline__ float grp8_sum(float v) { v += __shfl_xor(v, 1); v += __shfl_xor(v, 2); v += __shfl_xor(v, 4); return v; }
__device__ __forceinline__ float dpp_add(float v, float moved) { return v + moved; }
__device__ __forceinline__ float row16_sum(float v) {
    v += __int_as_float(__builtin_amdgcn_update_dpp(0, __float_as_int(v), 0x128, 0xf, 0xf, false));
    v += __int_as_float(__builtin_amdgcn_update_dpp(0, __float_as_int(v), 0x124, 0xf, 0xf, false));
    v += __int_as_float(__builtin_amdgcn_update_dpp(0, __float_as_int(v), 0x122, 0xf, 0xf, false));
    v += __int_as_float(__builtin_amdgcn_update_dpp(0, __float_as_int(v), 0x121, 0xf, 0xf, false));
    return v;
}
__device__ __forceinline__ float row8_sum(float v) {
    v += __int_as_float(__builtin_amdgcn_update_dpp(0, __float_as_int(v), 0xB1, 0xf, 0xf, false));
    v += __int_as_float(__builtin_amdgcn_update_dpp(0, __float_as_int(v), 0x4E, 0xf, 0xf, false));
    v += __int_as_float(__builtin_amdgcn_update_dpp(0, __float_as_int(v), 0x141, 0xf, 0xf, false));
    return v;
}

#define XB_TMO      128
#define XB_XCNT(j)  (256  + 64 * (j))
#define XB_XSUB(j)  (1280 + 64 * (j))
#define XB_XGEN(j)  (2304 + 64 * (j))
#define XB_TOP      3328
#define XB_TOPGEN   3392
#define XCD_BAR_WORDS 3456
#define XB_SPIN_CAP (1u << 20)

__device__ __forceinline__ unsigned xb_ld(unsigned* p)              { return __hip_atomic_load(p, __ATOMIC_RELAXED, __HIP_MEMORY_SCOPE_AGENT); }
__device__ __forceinline__ unsigned xb_add(unsigned* p, unsigned v) { return __hip_atomic_fetch_add(p, v, __ATOMIC_RELAXED, __HIP_MEMORY_SCOPE_AGENT); }
__device__ __forceinline__ unsigned xb_xcc_id() { return (unsigned)__builtin_amdgcn_s_getreg((3 << 11) | 20) & 0xFu; }
#define XB_SPIN(cond, bar) do { unsigned _sp = 0; while (cond) { __builtin_amdgcn_s_sleep(1); \
    if ((++_sp & 255u) == 0u) { if (xb_ld(&(bar)[XB_TMO])) break; if (_sp > XB_SPIN_CAP) { atomicAdd(&(bar)[XB_TMO], 1u); break; } } } } while (0)

struct XcdBarrier { unsigned* bar; unsigned x; volatile LAS unsigned* st; };

__device__ __forceinline__ XcdBarrier xcd_barrier_post(unsigned* bar, volatile LAS unsigned* st) {
    XcdBarrier b; b.bar = bar; b.x = xb_xcc_id(); b.st = st;
    if (threadIdx.x == 0) (void)xb_add(&bar[XB_XCNT(b.x)], 1u);
    return b;
}
__device__ __forceinline__ void xcd_barrier_complete(unsigned* bar, unsigned x, unsigned& nloc, unsigned& nx) {
    const unsigned G = gridDim.x * gridDim.y * gridDim.z;
    unsigned sum, cnt, mine, sp = 0u;
    for (;;) {
        sum = 0u; cnt = 0u; mine = 0u;
#pragma unroll
        for (unsigned j = 0; j < 16; ++j) { const unsigned c = xb_ld(&bar[XB_XCNT(j)]); sum += c; cnt += (c > 0u) ? 1u : 0u; mine = (j == x) ? c : mine; }
        if (sum == G) break;
        __builtin_amdgcn_s_sleep(1);
        if ((++sp & 255u) == 0u) { if (xb_ld(&bar[XB_TMO])) break; if (sp > XB_SPIN_CAP) { atomicAdd(&bar[XB_TMO], 1u); break; } }
    }
    nloc = mine > 0u ? mine : 1u; nx = cnt > 0u ? cnt : 1u;
}
__device__ __forceinline__ void xcd_barrier(const XcdBarrier& b) {
    asm volatile("s_waitcnt vmcnt(0)" ::: "memory");
    __syncthreads();
    if (threadIdx.x == 0) {
        unsigned* bar = b.bar;
        __builtin_amdgcn_s_waitcnt(0);
        unsigned nloc = b.st[0], nx = b.st[1];
        if (nloc == 0u) { xcd_barrier_complete(bar, b.x, nloc, nx); b.st[0] = nloc; b.st[1] = nx; }
        const unsigned old = xb_add(&bar[XB_XSUB(b.x)], 1u);
        const unsigned gen = old / nloc;
        if (old + 1u == (gen + 1u) * nloc) {
            __builtin_amdgcn_fence(__ATOMIC_RELEASE, "agent");
            asm volatile("s_waitcnt vmcnt(0)" ::: "memory");
            const unsigned og = xb_add(&bar[XB_TOP], 1u);
            const unsigned tg = og / nx;
            if (og + 1u == (tg + 1u) * nx) xb_add(&bar[XB_TOPGEN], 1u);
            else XB_SPIN(xb_ld(&bar[XB_TOPGEN]) == tg, bar);
            __builtin_amdgcn_fence(__ATOMIC_ACQUIRE, "agent");
            xb_add(&bar[XB_XGEN(b.x)], 1u);
            asm volatile("s_waitcnt vmcnt(0)" ::: "memory");
        } else {
            XB_SPIN(xb_ld(&bar[XB_XGEN(b.x)]) == gen, bar);
            __builtin_amdgcn_fence(__ATOMIC_ACQUIRE, "agent");
            asm volatile("s_waitcnt vmcnt(0)" ::: "memory");
        }
    }
    __syncthreads();
}

namespace pg8 {
constexpr int BM = 256, BK = 64, HALF = 128, HTB = HALF * BK * 2, STAGE_BYTES = 8 * HTB, NXCD = 8, WGM = 8;
__device__ __forceinline__ int lds_byte(int r, int c) { const int st = (r >> 4) * 2 + (c >> 5), rr = r & 15, cc = c & 31, ob = rr * 64 + cc * 2; return st * 1024 + (ob ^ (((ob >> 9) & 1) << 5)); }
__device__ __forceinline__ int perm32(int rho) { const int n = rho >> 4, i = rho & 15; return 8 * (i >> 2) + 4 * n + (i & 3); }
__device__ __forceinline__ void stage_rc(int b, int& R, int& C) { const int st = b / 1024, sb = b % 1024, swz = sb ^ (((sb >> 9) & 1) << 5); R = (st >> 1) * 16 + swz / 64; C = (st & 1) * 32 + (swz % 64) / 2; }

struct Unit { int pm, pn, tag; size_t aoff, boff; };
struct Gemm { const bf16_t* A; const bf16_t* Bt; int lda, ldb, K; };

typedef int i32x8 __attribute__((ext_vector_type(8)));
typedef int i32x4 __attribute__((ext_vector_type(4)));
__device__ __forceinline__ f32x4 mfma_f8(const bf16x8 w0, const bf16x8 w1, const bf16x8 a0, const bf16x8 a1, const f32x4 c) {
    const i32x4 wl = __builtin_bit_cast(i32x4, w0), wh = __builtin_bit_cast(i32x4, w1), al = __builtin_bit_cast(i32x4, a0), ah = __builtin_bit_cast(i32x4, a1);
    const i32x8 wv = __builtin_shufflevector(wl, wh, 0, 1, 2, 3, 4, 5, 6, 7), av = __builtin_shufflevector(al, ah, 0, 1, 2, 3, 4, 5, 6, 7);
    f32x4 d = c; asm volatile("v_mfma_f32_16x16x128_f8f6f4 %0, %1, %2, %0" : "+v"(d) : "v"(wv), "v"(av)); return d;
}
__device__ __forceinline__ void f8_settle(f32x4 (&acc)[2][2][4][2]) {
    asm volatile("s_nop 7\n\ts_nop 7\n\ts_nop 7");
#pragma unroll
    for (int a = 0; a < 2; ++a)
#pragma unroll
        for (int b = 0; b < 2; ++b)
#pragma unroll
            for (int m = 0; m < 4; ++m) asm volatile("" : "+v"(acc[a][b][m][0]), "+v"(acc[a][b][m][1]));
    __builtin_amdgcn_sched_barrier(0);
}
__device__ __forceinline__ bool static_tile(int i, int G, int c, int nM, int nN, int& pm, int& pn) {
    const int nwg = nM * nN; const long L = (long)i * G + c; if (L >= nwg) return false;
    int wgid = (int)L; { const int q = nwg / NXCD, r = nwg % NXCD, xcd = wgid % NXCD, off = wgid / NXCD; wgid = (xcd < r ? xcd * (q + 1) : r * (q + 1) + (xcd - r) * q) + off; }
    const int nig = WGM * nN, gid = wgid / nig, fm = gid * WGM, gsz = (nM - fm) < WGM ? (nM - fm) : WGM;
    pm = fm + ((wgid % nig) % gsz); pn = (wgid % nig) / gsz; return true;
}

template <bool FP8 = false, class Epi, class Sched>
__device__ __forceinline__ void gemm_phase(LAS unsigned char* lds, const Gemm g, const Sched& S, const Epi& E) {
    const int tid = threadIdx.x, wid = __builtin_amdgcn_readfirstlane(tid >> 6), lane = tid & 63, wr = wid >> 2, wc = wid & 3, fr = lane & 15, fq = lane >> 4;
    const int K = g.K, nt = K / BK;
    unsigned voffA[2], voffB[2];
#pragma unroll
    for (int i = 0; i < 2; ++i) { int R, C; stage_rc(tid * 16 + i * 8192, R, C);
        voffA[i] = (unsigned)(R * g.lda + C) * 2u; voffB[i] = (unsigned)(((R & ~31) + perm32(R & 31)) * g.ldb + C) * 2u; }
    const size_t kstep = (size_t)(BK * 2);
    const size_t hstepA = (size_t)HALF * g.lda * 2, hstepB = (size_t)HALF * g.ldb * 2;
    const unsigned ldsw = (unsigned)wid * 1024u;
    const int aoff = lds_byte(wr * 64 + fr, fq * 8), boff = lds_byte(wc * 32 + fr, fq * 8);
#define PG8_SA(b, h) (((b) * 2 + (h)) * HTB)
#define PG8_SB(b, h) ((4 + (b) * 2 + (h)) * HTB)
#define PG8_STAGE(bufoff, gbase, voff) do { _Pragma("unroll") for (int _i = 0; _i < 2; ++_i) \
        __builtin_amdgcn_global_load_lds((const unsigned*)((const char*)(gbase) + (voff)[_i]), (LAS unsigned*)(lds + (bufoff) + ldsw + _i * 8192), 16, 0, 0); } while (0)
#define PG8_LDA(dst, b, h) do { _Pragma("unroll") for (int m = 0; m < 4; ++m) _Pragma("unroll") for (int k = 0; k < 2; ++k) dst[m][k] = *(const LAS bf16x8*)(lds + PG8_SA(b, h) + aoff + m * 2048 + k * 1024); } while (0)
#define PG8_LDB(dst, b, h) do { _Pragma("unroll") for (int n = 0; n < 2; ++n) _Pragma("unroll") for (int k = 0; k < 2; ++k) dst[n][k] = *(const LAS bf16x8*)(lds + PG8_SB(b, h) + boff + n * 2048 + k * 1024); } while (0)
#define PG8_MMA(ai, bj, At, Bt) do { __builtin_amdgcn_s_setprio(1); _Pragma("unroll") for (int m = 0; m < 4; ++m) _Pragma("unroll") for (int n = 0; n < 2; ++n) { \
        if constexpr (FP8) acc[ai][bj][m][n] = mfma_f8(Bt[n][0], Bt[n][1], At[m][0], At[m][1], acc[ai][bj][m][n]); \
        else { _Pragma("unroll") for (int k = 0; k < 2; ++k) acc[ai][bj][m][n] = __builtin_amdgcn_mfma_f32_16x16x32_bf16(Bt[n][k], At[m][k], acc[ai][bj][m][n], 0, 0, 0); } } \
        __builtin_amdgcn_s_setprio(0); } while (0)
#define PG8_WAIT_V(n) asm volatile("s_waitcnt vmcnt(" #n ")" ::: "memory")
#define PG8_WAIT_L(n) asm volatile("s_waitcnt lgkmcnt(" #n ")" ::: "memory")
#define PG8_BAR __builtin_amdgcn_s_barrier()
#define PG8_SCHED __builtin_amdgcn_sched_barrier(0)
    Unit cur, nxt; int ui = 0;
    if (!S.next(0, cur)) return;
    f32x4 acc[2][2][4][2];
#pragma unroll
    for (int a = 0; a < 2; ++a)
#pragma unroll
        for (int b = 0; b < 2; ++b)
#pragma unroll
            for (int m = 0; m < 4; ++m)
#pragma unroll
                for (int n = 0; n < 2; ++n) acc[a][b][m][n] = (f32x4){0.f, 0.f, 0.f, 0.f};
    bf16x8 At[4][2], B0[2][2], B1[2][2];
    const char* cA = (const char*)g.A + cur.aoff; const char* cB = (const char*)g.Bt + cur.boff;
    PG8_STAGE(PG8_SB(0, 0), cB, voffB); PG8_STAGE(PG8_SA(0, 0), cA, voffA); PG8_STAGE(PG8_SB(0, 1), cB + hstepB, voffB); PG8_STAGE(PG8_SA(0, 1), cA + hstepA, voffA);
    if (wr == 1) PG8_BAR;
    PG8_WAIT_V(4); PG8_BAR;
    PG8_STAGE(PG8_SB(1, 0), cB + kstep, voffB); PG8_STAGE(PG8_SA(1, 0), cA + kstep, voffA); PG8_STAGE(PG8_SB(1, 1), cB + hstepB + kstep, voffB);
    PG8_WAIT_V(6); PG8_BAR;
    for (;;) {
        const bool has_next = S.next(ui + 1, nxt);
        const char* nA = has_next ? (const char*)g.A + nxt.aoff : cA; const char* nB = has_next ? (const char*)g.Bt + nxt.boff : cB;
        for (int t = 0; t < nt; t += 2) {
            const bool last = (t == nt - 2);
            const char* a1 = cA + (size_t)(t + 1) * kstep;
            const char* a2 = last ? nA : cA + (size_t)(t + 2) * kstep; const char* b2 = last ? nB : cB + (size_t)(t + 2) * kstep;
            const char* a3 = a2 + kstep; const char* b3 = b2 + kstep;
            PG8_LDB(B0, 0, 0); PG8_SCHED; PG8_LDA(At, 0, 0); PG8_STAGE(PG8_SA(1, 1), a1 + hstepA, voffA);
            PG8_WAIT_L(8); PG8_BAR; PG8_WAIT_L(0); PG8_MMA(0, 0, At, B0); PG8_BAR; PG8_SCHED;
            PG8_LDB(B1, 0, 1); PG8_STAGE(PG8_SB(0, 0), b2, voffB);
            PG8_BAR; PG8_WAIT_L(0); PG8_MMA(0, 1, At, B1); PG8_BAR;
            PG8_LDA(At, 0, 1); PG8_STAGE(PG8_SA(0, 0), a2, voffA);
            PG8_BAR; PG8_WAIT_L(0); PG8_MMA(1, 0, At, B0); PG8_BAR; PG8_SCHED;
            PG8_STAGE(PG8_SB(0, 1), b2 + hstepB, voffB);
            PG8_WAIT_V(6); PG8_BAR; PG8_MMA(1, 1, At, B1); PG8_BAR;
            PG8_LDB(B0, 1, 0); PG8_SCHED; PG8_LDA(At, 1, 0); PG8_STAGE(PG8_SA(0, 1), a2 + hstepA, voffA);
            PG8_WAIT_L(8); PG8_BAR; PG8_WAIT_L(0); PG8_MMA(0, 0, At, B0); PG8_BAR; PG8_SCHED;
            PG8_LDB(B1, 1, 1); PG8_STAGE(PG8_SB(1, 0), b3, voffB);
            PG8_BAR; PG8_WAIT_L(0); PG8_MMA(0, 1, At, B1); PG8_BAR;
            PG8_LDA(At, 1, 1); PG8_STAGE(PG8_SA(1, 0), a3, voffA);
            PG8_BAR; PG8_WAIT_L(0); PG8_MMA(1, 0, At, B0); PG8_BAR; PG8_SCHED;
            PG8_STAGE(PG8_SB(1, 1), b3 + hstepB, voffB);
            PG8_WAIT_V(6); PG8_BAR; PG8_MMA(1, 1, At, B1); PG8_BAR;
        }
        {
            if constexpr (FP8) f8_settle(acc);
            int tz = threadIdx.x; asm volatile("" : "+v"(tz));
            const int ewid = tz >> 6, elane = tz & 63;
            E(acc, cur, ewid >> 2, ewid & 3, elane & 15, elane >> 4); }
        if (!has_next) break;
#pragma unroll
        for (int a = 0; a < 2; ++a)
#pragma unroll
            for (int b = 0; b < 2; ++b)
#pragma unroll
                for (int m = 0; m < 4; ++m)
#pragma unroll
                    for (int n = 0; n < 2; ++n) acc[a][b][m][n] = (f32x4){0.f, 0.f, 0.f, 0.f};
        cur = nxt; cA = nA; cB = nB; ++ui;
    }
    PG8_WAIT_V(0);
    if (wr == 0) PG8_BAR;
    PG8_BAR;
#undef PG8_SA
#undef PG8_SB
#undef PG8_STAGE
#undef PG8_LDA
#undef PG8_LDB
#undef PG8_MMA
#undef PG8_WAIT_V
#undef PG8_WAIT_L
#undef PG8_BAR
#undef PG8_SCHED
}

template <bool FP8 = false, class Epi, class Sched>
__device__ __forceinline__ void gemm_phase_gather(LAS unsigned char* lds, const Gemm g, const int* tok, const Sched& S, const Epi& E) {
    const int tid = threadIdx.x, wid = __builtin_amdgcn_readfirstlane(tid >> 6), lane = tid & 63, wr = wid >> 2, wc = wid & 3, fr = lane & 15, fq = lane >> 4;
    const int K = g.K, nt = K / BK;
    unsigned vg0[2], vg1[2], ng0[2], ng1[2], voffB[2];
#pragma unroll
    for (int i = 0; i < 2; ++i) { int R, C; stage_rc(tid * 16 + i * 8192, R, C); voffB[i] = (unsigned)(((R & ~31) + perm32(R & 31)) * g.ldb + C) * 2u; }
#define PG8_GOFFS(d0_, d1_, tile_) do { _Pragma("unroll") for (int i_ = 0; i_ < 2; ++i_) { int R_, C_; stage_rc(tid * 16 + i_ * 8192, R_, C_); \
        const int t0_ = tok[(size_t)(tile_) * 256 + R_], t1_ = tok[(size_t)(tile_) * 256 + 128 + R_]; \
        d0_[i_] = (unsigned)(t0_ * g.lda + C_) * 2u; d1_[i_] = (unsigned)(t1_ * g.lda + C_) * 2u; } } while (0)
    const size_t kstep = (size_t)(BK * 2);
    const size_t hstepB = (size_t)HALF * g.ldb * 2;
    const unsigned ldsw = (unsigned)wid * 1024u;
    const int aoff = lds_byte(wr * 64 + fr, fq * 8), boff = lds_byte(wc * 32 + fr, fq * 8);
#define PG8_SA(b, h) (((b) * 2 + (h)) * HTB)
#define PG8_SB(b, h) ((4 + (b) * 2 + (h)) * HTB)
#define PG8_STAGE(bufoff, gbase, voff) do { _Pragma("unroll") for (int _i = 0; _i < 2; ++_i) \
        __builtin_amdgcn_global_load_lds((const unsigned*)((const char*)(gbase) + (voff)[_i]), (LAS unsigned*)(lds + (bufoff) + ldsw + _i * 8192), 16, 0, 0); } while (0)
#define PG8_STAGE_G(bufoff, koff, voff) do { _Pragma("unroll") for (int _i = 0; _i < 2; ++_i) \
        __builtin_amdgcn_global_load_lds((const unsigned*)((const char*)g.A + (unsigned)((voff)[_i] + (unsigned)(koff))), (LAS unsigned*)(lds + (bufoff) + ldsw + _i * 8192), 16, 0, 0); } while (0)
#define PG8_LDA(dst, b, h) do { _Pragma("unroll") for (int m = 0; m < 4; ++m) _Pragma("unroll") for (int k = 0; k < 2; ++k) dst[m][k] = *(const LAS bf16x8*)(lds + PG8_SA(b, h) + aoff + m * 2048 + k * 1024); } while (0)
#define PG8_LDB(dst, b, h) do { _Pragma("unroll") for (int n = 0; n < 2; ++n) _Pragma("unroll") for (int k = 0; k < 2; ++k) dst[n][k] = *(const LAS bf16x8*)(lds + PG8_SB(b, h) + boff + n * 2048 + k * 1024); } while (0)
#define PG8_MMA(ai, bj, At, Bt) do { __builtin_amdgcn_s_setprio(1); _Pragma("unroll") for (int m = 0; m < 4; ++m) _Pragma("unroll") for (int n = 0; n < 2; ++n) { \
        if constexpr (FP8) acc[ai][bj][m][n] = mfma_f8(Bt[n][0], Bt[n][1], At[m][0], At[m][1], acc[ai][bj][m][n]); \
        else { _Pragma("unroll") for (int k = 0; k < 2; ++k) acc[ai][bj][m][n] = __builtin_amdgcn_mfma_f32_16x16x32_bf16(Bt[n][k], At[m][k], acc[ai][bj][m][n], 0, 0, 0); } } \
        __builtin_amdgcn_s_setprio(0); } while (0)
#define PG8_WAIT_V(n) asm volatile("s_waitcnt vmcnt(" #n ")" ::: "memory")
#define PG8_WAIT_L(n) asm volatile("s_waitcnt lgkmcnt(" #n ")" ::: "memory")
#define PG8_BAR __builtin_amdgcn_s_barrier()
#define PG8_SCHED __builtin_amdgcn_sched_barrier(0)
    Unit cur, nxt; int ui = 0;
    if (!S.next(0, cur)) return;
    f32x4 acc[2][2][4][2];
#pragma unroll
    for (int a = 0; a < 2; ++a)
#pragma unroll
        for (int b = 0; b < 2; ++b)
#pragma unroll
            for (int m = 0; m < 4; ++m)
#pragma unroll
                for (int n = 0; n < 2; ++n) acc[a][b][m][n] = (f32x4){0.f, 0.f, 0.f, 0.f};
    bf16x8 At[4][2], B0[2][2], B1[2][2];
    const char* cB = (const char*)g.Bt + cur.boff;
    PG8_GOFFS(vg0, vg1, cur.pm);
    PG8_STAGE(PG8_SB(0, 0), cB, voffB); PG8_STAGE_G(PG8_SA(0, 0), 0, vg0); PG8_STAGE(PG8_SB(0, 1), cB + hstepB, voffB); PG8_STAGE_G(PG8_SA(0, 1), 0, vg1);
    if (wr == 1) PG8_BAR;
    PG8_WAIT_V(4); PG8_BAR;
    PG8_STAGE(PG8_SB(1, 0), cB + kstep, voffB); PG8_STAGE_G(PG8_SA(1, 0), kstep, vg0); PG8_STAGE(PG8_SB(1, 1), cB + hstepB + kstep, voffB);
    PG8_WAIT_V(6); PG8_BAR;
    for (;;) {
        const bool has_next = S.next(ui + 1, nxt);
        const char* nB = has_next ? (const char*)g.Bt + nxt.boff : cB;
        if (has_next) PG8_GOFFS(ng0, ng1, nxt.pm); else { ng0[0] = vg0[0]; ng0[1] = vg0[1]; ng1[0] = vg1[0]; ng1[1] = vg1[1]; }
        for (int t = 0; t < nt; t += 2) {
            const bool last = (t == nt - 2);
            const unsigned a1 = (unsigned)(t + 1) * (unsigned)kstep, a2 = last ? 0u : (unsigned)(t + 2) * (unsigned)kstep, a3 = a2 + (unsigned)kstep;
            const char* b2 = last ? nB : cB + (size_t)(t + 2) * kstep; const char* b3 = b2 + kstep;
            unsigned w0[2], w1[2];
            w0[0] = last ? ng0[0] : vg0[0]; w0[1] = last ? ng0[1] : vg0[1]; w1[0] = last ? ng1[0] : vg1[0]; w1[1] = last ? ng1[1] : vg1[1];
            PG8_LDB(B0, 0, 0); PG8_SCHED; PG8_LDA(At, 0, 0); PG8_STAGE_G(PG8_SA(1, 1), a1, vg1);
            PG8_WAIT_L(8); PG8_BAR; PG8_WAIT_L(0); PG8_MMA(0, 0, At, B0); PG8_BAR; PG8_SCHED;
            PG8_LDB(B1, 0, 1); PG8_STAGE(PG8_SB(0, 0), b2, voffB);
            PG8_BAR; PG8_WAIT_L(0); PG8_MMA(0, 1, At, B1); PG8_BAR;
            PG8_LDA(At, 0, 1); PG8_STAGE_G(PG8_SA(0, 0), a2, w0);
            PG8_BAR; PG8_WAIT_L(0); PG8_MMA(1, 0, At, B0); PG8_BAR; PG8_SCHED;
            PG8_STAGE(PG8_SB(0, 1), b2 + hstepB, voffB);
            PG8_WAIT_V(6); PG8_BAR; PG8_MMA(1, 1, At, B1); PG8_BAR;
            PG8_LDB(B0, 1, 0); PG8_SCHED; PG8_LDA(At, 1, 0); PG8_STAGE_G(PG8_SA(0, 1), a2, w1);
            PG8_WAIT_L(8); PG8_BAR; PG8_WAIT_L(0); PG8_MMA(0, 0, At, B0); PG8_BAR; PG8_SCHED;
            PG8_LDB(B1, 1, 1); PG8_STAGE(PG8_SB(1, 0), b3, voffB);
            PG8_BAR; PG8_WAIT_L(0); PG8_MMA(0, 1, At, B1); PG8_BAR;
            PG8_LDA(At, 1, 1); PG8_STAGE_G(PG8_SA(1, 0), a3, w0);
            PG8_BAR; PG8_WAIT_L(0); PG8_MMA(1, 0, At, B0); PG8_BAR; PG8_SCHED;
            PG8_STAGE(PG8_SB(1, 1), b3 + hstepB, voffB);
            PG8_WAIT_V(6); PG8_BAR; PG8_MMA(1, 1, At, B1); PG8_BAR;
        }
        {
            if constexpr (FP8) f8_settle(acc);
            int tz = threadIdx.x; asm volatile("" : "+v"(tz));
            const int ewid = tz >> 6, elane = tz & 63;
            E(acc, cur, ewid >> 2, ewid & 3, elane & 15, elane >> 4); }
        if (!has_next) break;
#pragma unroll
        for (int a = 0; a < 2; ++a)
#pragma unroll
            for (int b = 0; b < 2; ++b)
#pragma unroll
                for (int m = 0; m < 4; ++m)
#pragma unroll
                    for (int n = 0; n < 2; ++n) acc[a][b][m][n] = (f32x4){0.f, 0.f, 0.f, 0.f};
        cur = nxt; cB = nB; ++ui; vg0[0] = ng0[0]; vg0[1] = ng0[1]; vg1[0] = ng1[0]; vg1[1] = ng1[1];
    }
    PG8_WAIT_V(0);
    if (wr == 0) PG8_BAR;
    PG8_BAR;
#undef PG8_SA
#undef PG8_SB
#undef PG8_STAGE
#undef PG8_LDA
#undef PG8_LDB
#undef PG8_MMA
#undef PG8_WAIT_V
#undef PG8_WAIT_L
#undef PG8_BAR
#undef PG8_SCHED
#undef PG8_GOFFS
#undef PG8_STAGE_G
}

template <class F>
__device__ __forceinline__ void for_each_acc(const f32x4 (&acc)[2][2][4][2], const Unit& u, int wr, int wc, int fr, int fq, const F& f) {
    const int row0 = u.pm * BM + wr * 64 + fr, col0 = u.pn * BM + wc * 32 + 8 * fq;
#pragma unroll
    for (int ai = 0; ai < 2; ++ai)
#pragma unroll
        for (int m = 0; m < 4; ++m)
#pragma unroll
            for (int bj = 0; bj < 2; ++bj) { f(row0 + ai * HALF + m * 16, col0 + bj * HALF, acc[ai][bj][m][0], acc[ai][bj][m][1]); }
}
}

struct Args { const float* in[37]; float* out; unsigned char* ws; int ph_lo, ph_hi; };

struct Frame {
    LAS unsigned char* lds;
    int tid, lane, wave, G, bid;
    unsigned char* ws;
    float* out;
    unsigned* ctl;
};

__device__ __forceinline__ void st_bf16x4(bf16_t* p, const f32x4 v) { u32x2 o; o.x = pk2(v.x, v.y); o.y = pk2(v.z, v.w); *(u32x2*)p = o; }
__device__ __forceinline__ void st_bf16x8(bf16_t* p, const f32x4 a, const f32x4 b) { u32x4 o; o.x = pk2(a.x, a.y); o.y = pk2(a.z, a.w); o.z = pk2(b.x, b.y); o.w = pk2(b.z, b.w); *(u32x4*)p = o; }

struct PlainSched {
    int nM, nN, G, c; size_t a_tile, b_tile; int agrp; size_t astride;
    __device__ __forceinline__ bool next(int i, pg8::Unit& u) const {
        int pm, pn; if (!pg8::static_tile(i, G, c, nM, nN, pm, pn)) return false;
        u.pm = pm; u.pn = pn; u.tag = 0; u.aoff = (size_t)pm * a_tile + (agrp ? (size_t)(pn / agrp) * astride : 0); u.boff = (size_t)pn * b_tile; return true;
    }
};
struct RkvSched {
    int G, c; size_t a_tile, b_tile, astride;
    __device__ __forceinline__ bool next(int i, pg8::Unit& u) const {
        int pm, pn; constexpr int NLAT = (TL / 256) * 24;
        const long L = (long)i * G + c;
        if (L < NLAT) { if (!pg8::static_tile(0, G, (int)L, TL / 256, 24, pm, pn)) return false; }
        else { if (!pg8::static_tile(0, G, (int)(L - NLAT), TCX / 256, 16, pm, pn)) return false; pm += TL / 256; pn += 8; }
        u.pm = pm; u.pn = pn; u.tag = 0; u.aoff = (size_t)pm * a_tile + (size_t)(pn >> 3) * astride; u.boff = (size_t)pn * b_tile; return true;
    }
};
struct Four1Sched {
    int G, c;
    __device__ __forceinline__ bool next(int i, pg8::Unit& u) const {
        const long L = (long)i * G + c; if (L >= 1152) return false;
        const int l = (int)L;
        if (l < 1024) { const int batch = l >> 4, pm = (l >> 3) & 1, pn = l & 7, b = batch >> 2, g = batch & 3;
            u.pm = pm; u.pn = pn; u.tag = batch; u.aoff = (size_t)pm * 256 * 256; u.boff = ((size_t)(b * SEQ + pn * 256) * 1024 + g * 256); }
        else { const int uu = l - 1024, batch = uu >> 1, pm = uu & 1, b = batch >> 2, g = batch & 3;
            u.pm = pm; u.pn = 0; u.tag = 64 + batch; u.aoff = (size_t)pm * 256 * 256; u.boff = ((size_t)(TL + b * CTXL) * 1024 + g * 256); }
        return true;
    }
};
struct Four2Sched {
    int G, c, npm; size_t a_tile, b_batch;
    __device__ __forceinline__ bool next(int i, pg8::Unit& u) const {
        const long L = (long)i * G + c; if (L >= 64 * npm) return false;
        const int l = (int)L, batch = l / npm, pm = l % npm;
        u.pm = pm; u.pn = 0; u.tag = batch; u.aoff = (size_t)pm * a_tile; u.boff = (size_t)batch * b_batch; return true;
    }
};
struct RouterSched {
    int G, c, nM, rowbase;
    __device__ __forceinline__ bool next(int i, pg8::Unit& u) const {
        const long L = (long)i * G + c; if (L >= nM) return false;
        const int pm = (int)L, b = (pm * 256 < TL) ? (pm >> 3) : 16;
        u.pm = pm; u.pn = 0; u.tag = b; u.aoff = (size_t)pm * 256 * D * 2; u.boff = (size_t)(rowbase + 32 * b) * D * 2; return true;
    }
};
struct MoeSched {
    int G, c, NT; const LAS int* tstart; size_t a_tile, b_exp, b_tile;
    __device__ __forceinline__ bool next(int i, pg8::Unit& u) const {
        const long L = (long)i * G + c; const int total = __builtin_amdgcn_readfirstlane(tstart[32]) * NT; if (L >= total) return false;
        int l = (int)L; { const int q = total / 8, r = total % 8, xcd = l % 8, off = l / 8; l = (xcd < r ? xcd * (q + 1) : r * (q + 1) + (xcd - r) * q) + off; }
        const int tile = l / NT, pn = l % NT;
        int e = 0;
#pragma unroll 1
        for (int k = 1; k < 32; ++k) e += (__builtin_amdgcn_readfirstlane(tstart[k]) <= tile) ? 1 : 0;
        u.pm = tile; u.pn = pn; u.tag = e; u.aoff = (size_t)tile * a_tile; u.boff = (size_t)e * b_exp + (size_t)pn * b_tile; return true;
    }
};

typedef f32x4 AccT[2][2][4][2];
struct EpiInProj {
    bf16_t *Z, *XBC, *F; float* DT; const float* dt_bias;
    __device__ __forceinline__ void operator()(const AccT& acc, const pg8::Unit& u, int wr, int wc, int fr, int fq) const {
        pg8::for_each_acc(acc, u, wr, wc, fr, fq, [&](int r, int c, const f32x4 w0, const f32x4 w1) { const f32x4 v0 = w0 * F8_WINV, v1 = w1 * F8_WINV;
            if (c < 1024) st_bf16x8(Z + (size_t)r * 1024 + c, v0, v1);
            else if (c < 2560) st_bf16x8(XBC + (size_t)r * 1536 + (c - 1024), v0, v1);
            else if (c < 2592) { const int j = c - 2560; const f32x4 b0 = *(const f32x4*)(dt_bias + j), b1 = *(const f32x4*)(dt_bias + j + 4); f32x4 o0, o1;
                o0.x = softplusf_(v0.x + b0.x); o0.y = softplusf_(v0.y + b0.y); o0.z = softplusf_(v0.z + b0.z); o0.w = softplusf_(v0.w + b0.w);
                o1.x = softplusf_(v1.x + b1.x); o1.y = softplusf_(v1.y + b1.y); o1.z = softplusf_(v1.z + b1.z); o1.w = softplusf_(v1.w + b1.w);
                *(f32x4*)(DT + (size_t)r * 32 + j) = o0; *(f32x4*)(DT + (size_t)r * 32 + j + 4) = o1; }
            else if (c < NPROJ) { u32x2 p; p.x = pk4_f8(v0.x, v0.y, v0.z, v0.w); p.y = pk4_f8(v1.x, v1.y, v1.z, v1.w); *(u32x2*)((unsigned char*)F + (size_t)r * 1024 + (c - 2592)) = p; }
        });
    }
};
struct EpiFour1 {
    bf16_t *GL, *GC;
    __device__ __forceinline__ void operator()(const AccT& acc, const pg8::Unit& u, int wr, int wc, int fr, int fq) const {
        const bool lat = u.tag < 64; const int batch = lat ? u.tag : u.tag - 64; const int L = lat ? SEQ : CTXL;
        unsigned char* base = (unsigned char*)(lat ? +GL : +GC) + (size_t)batch * 512 * L;
        pg8::for_each_acc(acc, u, wr, wc, fr, fq, [&](int r, int c, const f32x4 v0, const f32x4 v1) {
            const f32x4 w0 = v0 * F8_WINV, w1 = v1 * F8_WINV;
            u32x2 p; p.x = pk4_f8(w0.x, w0.y, w0.z, w0.w); p.y = pk4_f8(w1.x, w1.y, w1.z, w1.w); *(u32x2*)(base + (size_t)r * L + c) = p; });
    }
};
struct EpiFour2 {
    bf16_t* MIX; int rowbase0, L;
    __device__ __forceinline__ void operator()(const AccT& acc, const pg8::Unit& u, int wr, int wc, int fr, int fq) const {
        const int b = u.tag >> 2, g = u.tag & 3;
        unsigned char* base = (unsigned char*)MIX + (size_t)(rowbase0 + b * L) * D + 1024 + g * 256;
        pg8::for_each_acc(acc, u, wr, wc, fr, fq, [&](int r, int c, const f32x4 v0, const f32x4 v1) {
            const f32x4 w0 = v0 * F8_WINV, w1 = v1 * F8_WINV;
            u32x2 p; p.x = pk4_f8(w0.x, w0.y, w0.z, w0.w); p.y = pk4_f8(w1.x, w1.y, w1.z, w1.w); *(u32x2*)(base + (size_t)r * D + c) = p; });
    }
};
template <bool RES_BF16>
struct EpiResid {
    bf16_t* V; const float* xl; const float* xc; const bf16_t* xb; const float* gate;
    __device__ __forceinline__ void operator()(const AccT& acc, const pg8::Unit& u, int wr, int wc, int fr, int fq) const {
        const int mr = (u.pm * 256 < TL) ? ((u.pm * 256) >> 11) : 16;
        const int col0 = u.pn * 256 + wc * 32 + 8 * fq;
        const float* gp = gate + (size_t)mr * 12288 + col0;
        const f32x4 g00 = *(const f32x4*)gp, g01 = *(const f32x4*)(gp + 4), g10 = *(const f32x4*)(gp + 128), g11 = *(const f32x4*)(gp + 132);
        pg8::for_each_acc(acc, u, wr, wc, fr, fq, [&](int r, int c, const f32x4 w0, const f32x4 w1) { const f32x4 v0 = w0 * F8_WINV, v1 = w1 * F8_WINV;
            const bool hi = (c - col0) != 0;
            const f32x4 g0 = hi ? g10 : g00, g1 = hi ? g11 : g01;
            f32x4 x0, x1;
            if (RES_BF16) { const u32x4 p = NTL((const u32x4*)(xb + (size_t)r * D + c)); x0.x = bflo(p.x); x0.y = bfhi(p.x); x0.z = bflo(p.y); x0.w = bfhi(p.y); x1.x = bflo(p.z); x1.y = bfhi(p.z); x1.z = bflo(p.w); x1.w = bfhi(p.w); }
            else { const float* xp = (r < TL) ? xl + (size_t)r * D + c : xc + (size_t)(r - TL) * D + c; x0 = NTL((const f32x4*)xp); x1 = NTL((const f32x4*)(xp + 4)); }
            f32x4 o0, o1;
            o0.x = ALPHA * x0.x + g0.x * v0.x; o0.y = ALPHA * x0.y + g0.y * v0.y; o0.z = ALPHA * x0.z + g0.z * v0.z; o0.w = ALPHA * x0.w + g0.w * v0.w;
            o1.x = ALPHA * x1.x + g1.x * v1.x; o1.y = ALPHA * x1.y + g1.y * v1.y; o1.z = ALPHA * x1.z + g1.z * v1.z; o1.w = ALPHA * x1.w + g1.w * v1.w;
            st_bf16x8(V + (size_t)r * D + c, o0, o1);
        });
    }
};
struct EpiRouter {
    float* LG; const float* bias;
    __device__ __forceinline__ void operator()(const AccT& acc, const pg8::Unit& u, int wr, int wc, int fr, int fq) const {
        pg8::for_each_acc(acc, u, wr, wc, fr, fq, [&](int r, int c, const f32x4 v0, const f32x4 v1) { if (c < 32) { const f32x4 b0 = *(const f32x4*)(bias + u.tag * 32 + c), b1 = *(const f32x4*)(bias + u.tag * 32 + c + 4);
            *(f32x4*)(LG + (size_t)r * 32 + c) = v0 + b0; *(f32x4*)(LG + (size_t)r * 32 + c + 4) = v1 + b1; } });
    }
};
struct EpiMoe1 {
    unsigned char* HID;
    __device__ __forceinline__ void operator()(const AccT& acc, const pg8::Unit& u, int wr, int wc, int fr, int fq) const {
        const int row0 = u.pm * 256 + wr * 64 + fr, col0 = u.pn * 128 + wc * 32 + 8 * fq;
#pragma unroll
        for (int ai = 0; ai < 2; ++ai)
#pragma unroll
            for (int m = 0; m < 4; ++m) { f32x4 o[2];
#pragma unroll
                for (int n = 0; n < 2; ++n) { const f32x4 g = acc[ai][0][m][n] * F8_WINV, up = acc[ai][1][m][n] * F8_WINV;
                    o[n].x = siluf_(g.x) * up.x; o[n].y = siluf_(g.y) * up.y; o[n].z = siluf_(g.z) * up.z; o[n].w = siluf_(g.w) * up.w; }
                u32x2 p; p.x = pk4_f8(o[0].x, o[0].y, o[0].z, o[0].w); p.y = pk4_f8(o[1].x, o[1].y, o[1].z, o[1].w);
                *(u32x2*)(HID + (size_t)(row0 + ai * 128 + m * 16) * 512 + col0) = p; }
    }
};
struct EpiBf16Plain {
    bf16_t* O; int ld; float scale;
    __device__ __forceinline__ void operator()(const AccT& acc, const pg8::Unit& u, int wr, int wc, int fr, int fq) const {
        pg8::for_each_acc(acc, u, wr, wc, fr, fq, [&](int r, int c, const f32x4 v0, const f32x4 v1) { st_bf16x8(O + (size_t)r * ld + c, v0 * scale, v1 * scale); });
    }
};
struct EpiF8Plain {
    unsigned char* O; int ld; float scale;
    __device__ __forceinline__ void operator()(const AccT& acc, const pg8::Unit& u, int wr, int wc, int fr, int fq) const {
        pg8::for_each_acc(acc, u, wr, wc, fr, fq, [&](int r, int c, const f32x4 v0, const f32x4 v1) { const f32x4 a = v0 * scale, b = v1 * scale;
            u32x2 p; p.x = pk4_f8(a.x, a.y, a.z, a.w); p.y = pk4_f8(b.x, b.y, b.z, b.w); *(u32x2*)(O + (size_t)r * ld + c) = p; });
    }
};
struct EpiRKV {
    bf16_t* R; long dK, dV;
    __device__ __forceinline__ void operator()(const AccT& acc, const pg8::Unit& u, int wr, int wc, int fr, int fq) const {
        const int grp = u.pn >> 3; bf16_t* base = R + (grp == 1 ? dK : 0l) + (grp == 2 ? dV : 0l);
        pg8::for_each_acc(acc, u, wr, wc, fr, fq, [&](int r, int c, const f32x4 v0, const f32x4 v1) { st_bf16x8(base + (size_t)r * D + (c & 2047), v0 * F8_WINV, v1 * F8_WINV); });
    }
};
struct EpiLora1 {
    bf16_t *TW, *TA, *TG;
    __device__ __forceinline__ void operator()(const AccT& acc, const pg8::Unit& u, int wr, int wc, int fr, int fq) const {
        const int grp = u.pn; unsigned char* base = (unsigned char*)(grp == 0 ? +TW : (grp == 1 ? +TA : +TG));
        pg8::for_each_acc(acc, u, wr, wc, fr, fq, [&](int r, int c, f32x4 v0, f32x4 v1) { v0 *= F8_WINV; v1 *= F8_WINV;
            if (grp == 0) { v0.x = tanhf(v0.x); v0.y = tanhf(v0.y); v0.z = tanhf(v0.z); v0.w = tanhf(v0.w); v1.x = tanhf(v1.x); v1.y = tanhf(v1.y); v1.z = tanhf(v1.z); v1.w = tanhf(v1.w); }
            else if (grp == 2) { v0.x = sigmoidf_(v0.x); v0.y = sigmoidf_(v0.y); v0.z = sigmoidf_(v0.z); v0.w = sigmoidf_(v0.w); v1.x = sigmoidf_(v1.x); v1.y = sigmoidf_(v1.y); v1.z = sigmoidf_(v1.z); v1.w = sigmoidf_(v1.w); }
            u32x2 p; p.x = pk4_f8(v0.x, v0.y, v0.z, v0.w); p.y = pk4_f8(v1.x, v1.y, v1.z, v1.w);
            *(u32x2*)(base + (size_t)r * 256 + (c & 255)) = p; });
    }
};
struct EpiSigGrp {
    bf16_t *O0, *O1; const float* bias;
    __device__ __forceinline__ void operator()(const AccT& acc, const pg8::Unit& u, int wr, int wc, int fr, int fq) const {
        const int e = u.pn >> 3; bf16_t* base = O0 + (e ? (O1 - O0) : 0l);
        const int col0 = u.pn * 256 + wc * 32 + 8 * fq;
        const float* bp = bias + e * 2048 + (col0 & 2047);
        const f32x4 b00 = *(const f32x4*)bp, b01 = *(const f32x4*)(bp + 4), b10 = *(const f32x4*)(bp + 128), b11 = *(const f32x4*)(bp + 132);
        pg8::for_each_acc(acc, u, wr, wc, fr, fq, [&](int r, int c, const f32x4 v0, const f32x4 v1) {
            const bool hi = (c - col0) != 0;
            st_bf16x8(base + (size_t)r * D + (c & 2047), v0 * F8_WINV + (hi ? b10 : b00), v1 * F8_WINV + (hi ? b11 : b01)); });
    }
};

__device__ __forceinline__ void transpose_item(const float* W, int N, int k0, int n0, bf16_t* dst, int ldd, LAS float* scr, int lane) {
#pragma unroll 8
    for (int i = 0; i < 32; ++i) { const int kk = 2 * i + (lane >> 5); scr[kk * 33 + (lane & 31)] = NTL(W + (size_t)(k0 + kk) * N + n0 + (lane & 31)); }
    asm volatile("s_waitcnt lgkmcnt(0)" ::: "memory");
    const int c = lane & 7;
#pragma unroll
    for (int j = 0; j < 4; ++j) { const int n = (lane >> 3) + 8 * j; const LAS float* s = scr + (8 * c) * 33 + n;
        u32x4 o; o.x = pk2(s[0 * 33], s[1 * 33]); o.y = pk2(s[2 * 33], s[3 * 33]); o.z = pk2(s[4 * 33], s[5 * 33]); o.w = pk2(s[6 * 33], s[7 * 33]);
        *(u32x4*)(dst + (size_t)n * ldd + 8 * c) = o; }
    asm volatile("s_waitcnt lgkmcnt(0)" ::: "memory");
}
__device__ __forceinline__ void transpose_plain(const float* W, int K, int N, bf16_t* dst, int ldd, int item, LAS float* scr, int lane) {
    const int nblk = N / 32, kb = item / nblk, nb = item % nblk;
    transpose_item(W, N, kb * 64, nb * 32, dst + (size_t)(nb * 32) * ldd + kb * 64, ldd, scr, lane);
}
__device__ __forceinline__ void transpose_item_f8(const float* W, int N, int k0, int n0, unsigned char* dst, int ldd, LAS float* scr, int lane) {
#pragma unroll 8
    for (int i = 0; i < 32; ++i) { const int kk = 2 * i + (lane >> 5); scr[kk * 33 + (lane & 31)] = NTL(W + (size_t)(k0 + kk) * N + n0 + (lane & 31)); }
    asm volatile("s_waitcnt lgkmcnt(0)" ::: "memory");
    const int c = lane & 7;
#pragma unroll
    for (int j = 0; j < 4; ++j) { const int n = (lane >> 3) + 8 * j; const LAS float* sp = scr + (8 * c) * 33 + n;
        u32x2 o; o.x = pk4_f8(sp[0 * 33] * F8_WSCALE, sp[1 * 33] * F8_WSCALE, sp[2 * 33] * F8_WSCALE, sp[3 * 33] * F8_WSCALE);
        o.y = pk4_f8(sp[4 * 33] * F8_WSCALE, sp[5 * 33] * F8_WSCALE, sp[6 * 33] * F8_WSCALE, sp[7 * 33] * F8_WSCALE);
        *(u32x2*)(dst + (size_t)n * ldd + 8 * c) = o; }
    asm volatile("s_waitcnt lgkmcnt(0)" ::: "memory");
}
__device__ __forceinline__ void transpose_plain_f8(const float* W, int K, int N, unsigned char* dst, int ldd, int item, LAS float* scr, int lane) {
    const int nblk = N / 32, kb = item / nblk, nb = item % nblk;
    transpose_item_f8(W, N, kb * 64, nb * 32, dst + (size_t)(nb * 32) * ldd + kb * 64, ldd, scr, lane);
}
__device__ __forceinline__ void moe_convert_item(const float* wg, const float* wu, const float* wd, bf16_t* moe, int item, LAS float* scr, int lane) {
    const int e = item / 1536, r = item % 1536;
    unsigned char* eb = (unsigned char*)moe + (size_t)e * MOE_E_ELEMS;
    if (r < 1024) { const int mat = r >> 9, it = r & 511;
        const float* W = (mat ? wu : wg) + (size_t)e * 2048 * 512;
        const int kb = it / 16, nb = it % 16, n0 = nb * 32, pn = n0 >> 7, j = n0 & 127;
        transpose_item_f8(W, 512, kb * 64, n0, eb + (size_t)(pn * 256 + mat * 128 + j) * 2048 + kb * 64, 2048, scr, lane);
    } else { const int it = r - 1024;
        const float* W = wd + (size_t)e * 512 * 2048;
        const int kb = it / 64, nb = it % 64;
        transpose_item_f8(W, 2048, kb * 64, nb * 32, eb + (size_t)1024 * 2048 + (size_t)(nb * 32) * 512 + kb * 64, 512, scr, lane);
    }
}

constexpr int CVT_PER_IDLE_UNIT = 13;
__device__ __forceinline__ void moe_convert_tail(Frame& F, const Args& a, int U, int base) {
    const int first_idle = U % F.G;
    if (first_idle == 0 || F.bid < first_idle) return;
    LAS float* scr = (LAS float*)(F.lds + F.wave * 8704);
    const int nwk = (F.G - first_idle) * NWAVES, wk = (F.bid - first_idle) * NWAVES + F.wave;
    for (int k = 0; k < CVT_PER_IDLE_UNIT; ++k) { const int it = base + k * nwk + wk; if (it < 32 * 1536) moe_convert_item(a.in[34], a.in[35], a.in[36], (bf16_t*)(F.ws + WS_MOE), it, scr, F.lane); }
}
__device__ __forceinline__ int cvt_tail_items(int U, int G) { const int fi = U % G; return fi ? (G - fi) * NWAVES * CVT_PER_IDLE_UNIT : 0; }
__device__ __forceinline__ void moe_convert_rest(Frame& F, const Args& a, int first) {
    LAS float* scr = (LAS float*)(F.lds + F.wave * 8704);
    for (int it = first + F.bid * NWAVES + F.wave; it < 32 * 1536; it += F.G * NWAVES) moe_convert_item(a.in[34], a.in[35], a.in[36], (bf16_t*)(F.ws + WS_MOE), it, scr, F.lane);
}

__device__ __forceinline__ void phase_prologue(Frame& F, const Args& a) {
    LAS float* scr = (LAS float*)(F.lds + F.wave * 8704);
    const int gw = F.bid * NWAVES + F.wave, NGW = F.G * NWAVES;
    unsigned char* ws = F.ws;
    bf16_t* WIN = (bf16_t*)(ws + WS_WIN); bf16_t* WOUT = (bf16_t*)(ws + WS_WOUT); bf16_t* BT1 = (bf16_t*)(ws + WS_BT1);
    bf16_t* G2T = (bf16_t*)(ws + WS_G2T); bf16_t* WOT = (bf16_t*)(ws + WS_WOT); bf16_t* ROUT = (bf16_t*)(ws + WS_ROUT);
    constexpr int I_IN = 32 * 113, I_SQ = 32 * 64, I_L96 = 32 * 3, I_G1 = 32 * 8, I_G2 = 4 * 64, I_RT = 32;
    constexpr int NITEMS = I_IN + I_SQ + 3 * I_SQ + 4 * I_L96 + I_G1 + I_G2 + I_SQ + I_RT;
    for (int it = gw; it < NITEMS; it += NGW) {
        int r = it;
        if (r < I_IN) { transpose_plain_f8(a.in[8], 2048, NPROJ, (unsigned char*)WIN, 2048, r, scr, F.lane); continue; } r -= I_IN;
        if (r < I_SQ) { transpose_plain_f8(a.in[15], 2048, 2048, (unsigned char*)WOUT, 2048, r, scr, F.lane); continue; } r -= I_SQ;
        if (r < 3 * I_SQ) { const int j = r / I_SQ; transpose_plain_f8(a.in[17] + (size_t)j * 2048 * 2048, 2048, 2048, (unsigned char*)BT1 + (size_t)j * 2048 * 2048, 2048, r % I_SQ, scr, F.lane); continue; } r -= 3 * I_SQ;
        if (r < 2 * I_L96) { const int e = r / I_L96; transpose_plain_f8(a.in[20] + (size_t)e * 2048 * 96, 2048, 96, (unsigned char*)BT1 + (size_t)(6144 + e * 96) * 2048, 2048, r % I_L96, scr, F.lane); continue; } r -= 2 * I_L96;
        if (r < 2 * I_L96) { const int e = r / I_L96; transpose_plain_f8(a.in[23] + (size_t)e * 2048 * 96, 2048, 96, (unsigned char*)BT1 + (size_t)(6400 + e * 96) * 2048, 2048, r % I_L96, scr, F.lane); continue; } r -= 2 * I_L96;
        if (r < I_G1) { transpose_plain_f8(a.in[25], 2048, 256, (unsigned char*)BT1 + (size_t)6656 * 2048, 2048, r, scr, F.lane); continue; } r -= I_G1;
        if (r < I_G2) { transpose_plain_f8(a.in[26], 256, 2048, (unsigned char*)G2T, 256, r, scr, F.lane); continue; } r -= I_G2;
        if (r < I_SQ) { transpose_plain_f8(a.in[18], 2048, 2048, (unsigned char*)WOT, 2048, r, scr, F.lane); continue; } r -= I_SQ;
        transpose_plain(a.in[32], 2048, 32, ROUT, 2048, r, scr, F.lane);
    }
    const size_t gt = (size_t)F.bid * NTHREADS + F.tid, NGT = (size_t)F.G * NTHREADS;
    {   unsigned char* B2W = ws + WS_BT2W; unsigned char* B2A = ws + WS_BT2A;
        for (size_t i4 = gt; i4 < (size_t)2 * 4096 * 64; i4 += NGT) {
            const int which = (int)(i4 / (4096 * 64)); const int rem = (int)(i4 % (4096 * 64));
            const int nrow = rem % 4096, k4 = rem / 4096, e = nrow >> 11, n = nrow & 2047;
            const float* src = which ? a.in[24] : a.in[21]; float v[4];
#pragma unroll
            for (int x = 0; x < 4; ++x) { const int k = 4 * k4 + x - e * 96; v[x] = (k >= 0 && k < 96) ? src[((size_t)e * 96 + k) * 2048 + n] * F8_WSCALE : 0.f; }
            *(unsigned*)((which ? B2A : B2W) + (size_t)nrow * 256 + 4 * k4) = pk4_f8(v[0], v[1], v[2], v[3]);
        }
    }
    {   const u32x4 z = (u32x4){0u, 0u, 0u, 0u};
        u32x4* p0 = (u32x4*)((unsigned char*)WIN + (size_t)NPROJ * 2048); const size_t n0 = (size_t)(NPROJ_PAD - NPROJ) * 2048 / 16;
        for (size_t i = gt; i < n0; i += NGT) p0[i] = z;
        u32x4* p1 = (u32x4*)((unsigned char*)BT1 + (size_t)6336 * 2048); u32x4* p2 = (u32x4*)((unsigned char*)BT1 + (size_t)6592 * 2048); const size_t n1 = (size_t)64 * 2048 / 16;
        for (size_t i = gt; i < n1; i += NGT) { p1[i] = z; p2[i] = z; }
        u32x4* p3 = (u32x4*)(ROUT + (size_t)32 * 2048); const size_t n3 = (size_t)224 * 2048 / 8;
        for (size_t i = gt; i < n3; i += NGT) p3[i] = z;
    }
    {   bf16_t* T1 = (bf16_t*)(ws + WS_TW1); bf16_t* T2L = (bf16_t*)(ws + WS_TW2L); bf16_t* T2C = (bf16_t*)(ws + WS_TW2C);
        const float TWO_PI = 6.283185307179586f;
        for (size_t i4 = gt; i4 < (size_t)512 * 64; i4 += NGT) { const size_t idx = i4 * 4; const int m = (int)(idx >> 8), cc = (int)(idx & 255), n = m >> 1, part = m & 1; float v[4];
#pragma unroll
            for (int x = 0; x < 4; ++x) { const float ang = TWO_PI * (float)((n * (cc + x)) & 255) * (1.f / 256.f); v[x] = (part ? -sinf(ang) : cosf(ang)) * ((1.f / 16.f) * F8_WSCALE); }
            *(unsigned*)((unsigned char*)T1 + idx) = pk4_f8(v[0], v[1], v[2], v[3]); }
        for (size_t i4 = gt; i4 < (size_t)2048 * 4096 / 4; i4 += NGT) { const size_t idx = i4 * 4; const int lp = (int)(idx >> 12), kk = (int)(idx & 4095), part = kk >> 11, l = kk & 2047; float v[4];
#pragma unroll
            for (int x = 0; x < 4; ++x) { const float ang = TWO_PI * (float)((lp * (l + x)) & 2047) * (1.f / 2048.f); v[x] = (part ? sinf(ang) : cosf(ang)) * (0.022097086912079608f * F8_WSCALE); }
            *(unsigned*)((unsigned char*)T2L + idx) = pk4_f8(v[0], v[1], v[2], v[3]); }
        for (size_t i4 = gt; i4 < (size_t)256 * 512 / 4; i4 += NGT) { const size_t idx = i4 * 4; const int lp = (int)(idx >> 9), kk = (int)(idx & 511), part = kk >> 8, l = kk & 255; float v[4];
#pragma unroll
            for (int x = 0; x < 4; ++x) { const float ang = TWO_PI * (float)((lp * (l + x)) & 255) * (1.f / 256.f); v[x] = (part ? sinf(ang) : cosf(ang)) * ((1.f / 16.f) * F8_WSCALE); }
            *(unsigned*)((unsigned char*)T2C + idx) = pk4_f8(v[0], v[1], v[2], v[3]); }
    }
    {   float* MOD = (float*)(ws + WS_MOD);
        LAS float* sl = (LAS float*)F.lds;
        LAS float* red = (LAS float*)(F.lds + 139264);
        const int kq = F.tid >> 5, nl = F.tid & 31;
        __syncthreads();
        for (int idx = F.tid; idx < 17 * 2048; idx += NTHREADS) { const int r = idx >> 11, kk = idx & 2047;
            const float cvv = (r < 16) ? a.in[1][r * 2048 + kk] : a.in[3][kk]; sl[idx] = siluf_(cvv); }
        __syncthreads();
        for (int unit = F.bid; unit < 768; unit += F.G) {
            const int i = unit / 384, n0 = (unit % 384) * 32;
            const float* Wp = a.in[4] + (size_t)i * 2048 * 12288 + (size_t)(kq * 128) * 12288 + n0 + nl;
            float accv[17];
#pragma unroll
            for (int r = 0; r < 17; ++r) accv[r] = 0.f;
#pragma unroll 1
            for (int kb = 0; kb < 16; ++kb) { float wv[8];
#pragma unroll
                for (int x = 0; x < 8; ++x) wv[x] = NTL(Wp + (size_t)(kb * 8 + x) * 12288);
#pragma unroll
                for (int x4 = 0; x4 < 2; ++x4) {
#pragma unroll
                    for (int r = 0; r < 17; ++r) { const f32x4 sv = *(const LAS f32x4*)(sl + r * 2048 + kq * 128 + kb * 8 + x4 * 4);
                        accv[r] += wv[4 * x4] * sv.x + wv[4 * x4 + 1] * sv.y + wv[4 * x4 + 2] * sv.z + wv[4 * x4 + 3] * sv.w; }
                    __builtin_amdgcn_sched_barrier(0); } }
#pragma unroll
            for (int r = 0; r < 17; ++r) { accv[r] += __shfl_xor(accv[r], 32); if ((F.tid & 32) == 0) red[((kq >> 1) * 17 + r) * 32 + nl] = accv[r]; }
            __syncthreads();
            for (int idx = F.tid; idx < 17 * 32; idx += NTHREADS) { const int r = idx >> 5, n = idx & 31; float sacc = a.in[5][i * 12288 + n0 + n];
#pragma unroll
                for (int q = 0; q < 8; ++q) sacc += red[(q * 17 + r) * 32 + n];
                MOD[((size_t)i * 17 + r) * 12288 + n0 + n] = sacc; }
            __syncthreads();
        }
    }
}

#define LNC(j) (8 * F.lane + 512 * (j))
__device__ __forceinline__ void phase_modulate0(Frame& F, const Args& a) {
    const int gw = F.bid * NWAVES + F.wave, NGW = F.G * NWAVES;
    const float* MOD = (const float*)(F.ws + WS_MOD);
    bf16_t* H = (bf16_t*)(F.ws + WSLOT(0));
    const int rpw = (T + NGW - 1) / NGW, r0 = gw * rpw, r1 = (r0 + rpw < T) ? r0 + rpw : T;
    f32x4 scv[4][2], shv[4][2]; int cur = -1;
    for (int rb = r0; rb < r1; rb += 2) {
        f32x4 x[2][4][2];
#pragma unroll
        for (int u = 0; u < 2; ++u) { const int r = rb + u; if (r < r1) { const float* src = r < TL ? a.in[0] + (size_t)r * D : a.in[2] + (size_t)(r - TL) * D;
#pragma unroll
            for (int j = 0; j < 4; ++j)
#pragma unroll
                for (int h = 0; h < 2; ++h) x[u][j][h] = NTL((const f32x4*)(src + LNC(j) + 4 * h)); } }
#pragma unroll
        for (int u = 0; u < 2; ++u) { const int r = rb + u; if (r < r1) {
            const int mr = r < TL ? (r >> 11) : 16;
            if (mr != cur) { cur = mr; const float* sh = MOD + (size_t)mr * 12288; const float* sc = sh + 2048;
#pragma unroll
                for (int j = 0; j < 4; ++j)
#pragma unroll
                    for (int h = 0; h < 2; ++h) { const int c = LNC(j) + 4 * h; const f32x4 s1 = *(const f32x4*)(sc + c); shv[j][h] = *(const f32x4*)(sh + c);
                        scv[j][h].x = 1.f + s1.x; scv[j][h].y = 1.f + s1.y; scv[j][h].z = 1.f + s1.z; scv[j][h].w = 1.f + s1.w; } }
#pragma unroll
            for (int j = 0; j < 4; ++j) { f32x4 o[2];
#pragma unroll
                for (int h = 0; h < 2; ++h) { const f32x4 xv = x[u][j][h];
                    o[h].x = xv.x * scv[j][h].x + shv[j][h].x; o[h].y = xv.y * scv[j][h].y + shv[j][h].y; o[h].z = xv.z * scv[j][h].z + shv[j][h].z; o[h].w = xv.w * scv[j][h].w + shv[j][h].w; }
                u32x2 p; p.x = pk4_f8(o[0].x, o[0].y, o[0].z, o[0].w); p.y = pk4_f8(o[1].x, o[1].y, o[1].z, o[1].w);
                *(u32x2*)((unsigned char*)H + (size_t)r * D + LNC(j)) = p; } } }
    }
}
__device__ __forceinline__ void phase_router_build(Frame& F, const Args& a) {
    const size_t gt = (size_t)F.bid * NTHREADS + F.tid, NGT = (size_t)F.G * NTHREADS;
    const float* Wr = a.in[32]; bf16_t* RB = (bf16_t*)(F.ws + WS_ROUTB);
    const float* MOD = (const float*)(F.ws + WS_MOD);
    for (size_t i8 = gt; i8 < (size_t)1056 * 256; i8 += NGT) {
        const int row = (int)(i8 >> 8), k0 = (int)(i8 & 255) * 8, layer = row >= 544 ? 1 : 0, rr = row - 544 * layer, b = rr >> 5, e = rr & 31;
        const float* sc = MOD + (size_t)layer * 17 * 12288 + (size_t)b * 12288 + 4 * 2048 + k0;
        float o[8];
#pragma unroll
        for (int x = 0; x < 8; ++x) o[x] = (1.f + sc[x]) * Wr[(size_t)(k0 + x) * 32 + e];
        *(u32x4*)(RB + (size_t)row * D + k0) = pack8(o);
    }
    const int gw = F.bid * NWAVES + F.wave, NGW = F.G * NWAVES;
    for (int row = gw; row < 1056; row += NGW) {
        const int layer = row >= 544 ? 1 : 0, rr = row - 544 * layer, b = rr >> 5, e = rr & 31;
        const float* sh = MOD + (size_t)layer * 17 * 12288 + (size_t)b * 12288 + 3 * 2048;
        float acc = 0.f;
        for (int k = F.lane; k < D; k += 64) acc += sh[k] * Wr[(size_t)k * 32 + e];
        acc = wave_sum(acc);
        if (F.lane == 0) ((float*)(F.ctl + CW_RB))[row] = acc;
    }
}
__device__ __forceinline__ void phase_conv(Frame& F, const Args& a) {
    const int gw = F.bid * NWAVES + F.wave, NGW = F.G * NWAVES;
    const bf16_t* XBC = (const bf16_t*)(F.ws + WSLOT(2)); bf16_t* XC = (bf16_t*)(F.ws + WSLOT(3));
    const float* cw = a.in[9]; const float* cb = a.in[10];
    float w0[3][8], w1[3][8], w2[3][8], bb[3][8];
#pragma unroll
    for (int j = 0; j < 3; ++j)
#pragma unroll
        for (int q = 0; q < 8; ++q) { const int ch = 8 * F.lane + 512 * j + q; w0[j][q] = cw[ch]; w1[j][q] = cw[1536 + ch]; w2[j][q] = cw[3072 + ch]; bb[j][q] = cb[ch]; }
    for (int r = gw; r < T; r += NGW) {
        int l, L; if (r < TL) { l = r & 2047; L = SEQ; } else { l = (r - TL) & 255; L = CTXL; }
        const bool hp = l > 0, hn = l < L - 1;
#pragma unroll
        for (int j = 0; j < 3; ++j) { const int ch = 8 * F.lane + 512 * j;
            const u32x4 z4 = (u32x4){0u, 0u, 0u, 0u};
            const u32x4 xm = *(const u32x4*)(XBC + (size_t)r * 1536 + ch);
            const u32x4 xp = hp ? *(const u32x4*)(XBC + (size_t)(r - 1) * 1536 + ch) : z4;
            const u32x4 xn = hn ? *(const u32x4*)(XBC + (size_t)(r + 1) * 1536 + ch) : z4;
            float fm[8], fp[8], fn[8], o[8]; unpack8(xm, fm); unpack8(xp, fp); unpack8(xn, fn);
#pragma unroll
            for (int q = 0; q < 8; ++q) { const float v = bb[j][q] + w0[j][q] * fp[q] + w1[j][q] * fm[q] + w2[j][q] * fn[q]; o[q] = siluf_(v); }
            *(u32x4*)(XC + (size_t)r * 1536 + ch) = pack8(o); }
    }
}
__device__ __forceinline__ void phase_ssd_out(Frame& F, const Args& a) {
    const int gw = F.bid * NWAVES + F.wave, NGW = F.G * NWAVES;
    const bf16_t* Y0 = (const bf16_t*)(F.ws + WSLOT(4)); const bf16_t* Y1 = Y0 + (size_t)T * 1024;
    const bf16_t* Z = (const bf16_t*)(F.ws + WSLOT(1)); const bf16_t* XC = (const bf16_t*)(F.ws + WSLOT(3)); bf16_t* MIX = (bf16_t*)(F.ws + WSLOT(5));
    const int g = gw & 1, ch = g * 512 + 8 * F.lane;
    const float dh = a.in[13][ch >> 6];
    float nwv[8];
#pragma unroll
    for (int q = 0; q < 8; ++q) nwv[q] = a.in[14][ch + q];
    for (int it0 = gw; it0 < 2 * T; it0 += 2 * NGW) {
        u32x4 q[2][4];
#pragma unroll
        for (int u = 0; u < 2; ++u) { const int it = it0 + u * NGW; if (it < 2 * T) { const int r = it >> 1;
            q[u][0] = NTL((const u32x4*)(Y0 + (size_t)r * 1024 + ch)); q[u][1] = NTL((const u32x4*)(Y1 + (size_t)r * 1024 + ch));
            q[u][2] = NTL((const u32x4*)(Z + (size_t)r * 1024 + ch)); q[u][3] = NTL((const u32x4*)(XC + (size_t)r * 1536 + ch)); } }
#pragma unroll
        for (int u = 0; u < 2; ++u) { const int it = it0 + u * NGW; if (it < 2 * T) { const int r = it >> 1;
            float y0[8], y1[8], z[8], xs[8], uu[8];
            unpack8(q[u][0], y0); unpack8(q[u][1], y1); unpack8(q[u][2], z); unpack8(q[u][3], xs);
            float ss = 0.f;
#pragma unroll
            for (int x = 0; x < 8; ++x) { uu[x] = (y0[x] + y1[x] + dh * xs[x]) * siluf_(z[x]); ss += uu[x] * uu[x]; }
            ss = wave_sum(ss);
            const float rs = rsqrtf(ss * (1.f / 512.f) + LN_EPS);
#pragma unroll
            for (int x = 0; x < 8; ++x) uu[x] = uu[x] * rs * nwv[x];
            u32x2 p; p.x = pk4_f8(uu[0], uu[1], uu[2], uu[3]); p.y = pk4_f8(uu[4], uu[5], uu[6], uu[7]); *(u32x2*)((unsigned char*)MIX + (size_t)r * D + ch) = p; } }
    }
}
__device__ __forceinline__ void phase_ln_mid(Frame& F, const Args& a, int layer, int nrows, const bf16_t* V, bf16_t* X1, bf16_t* H, unsigned char* H8) {
    const int gw = F.bid * NWAVES + F.wave, NGW = F.G * NWAVES;
    const float* MOD = (const float*)(F.ws + WS_MOD) + (size_t)layer * 17 * 12288;
    const float* lg = a.in[6] + (size_t)(layer * 2 + 0) * D; const float* lb = a.in[7] + (size_t)(layer * 2 + 0) * D;
    const int rpw = (nrows + NGW - 1) / NGW, r0 = gw * rpw, r1 = (r0 + rpw < nrows) ? r0 + rpw : nrows;
    f32x4 lgv[4][2], lbv[4][2], scv[4][2], shv[4][2]; int cur = -1;
#pragma unroll
    for (int j = 0; j < 4; ++j)
#pragma unroll
        for (int h = 0; h < 2; ++h) { lgv[j][h] = *(const f32x4*)(lg + LNC(j) + 4 * h); lbv[j][h] = *(const f32x4*)(lb + LNC(j) + 4 * h); }
    for (int rb = r0; rb < r1; rb += 2) {
      u32x4 raw[2][4];
#pragma unroll
      for (int u = 0; u < 2; ++u) if (rb + u < r1) {
#pragma unroll
          for (int j = 0; j < 4; ++j) raw[u][j] = NTL((const u32x4*)(V + (size_t)(rb + u) * D + LNC(j))); }
#pragma unroll
      for (int u = 0; u < 2; ++u) { const int r = rb + u; if (r >= r1) break;
        u32x4 cu[4];
#pragma unroll
        for (int j = 0; j < 4; ++j) cu[j] = raw[u][j];
        const int mr = r < TL ? (r >> 11) : 16;
        if (mr != cur) { cur = mr; const float* sh = MOD + (size_t)mr * 12288 + 3 * 2048; const float* sc = sh + 2048;
#pragma unroll
            for (int j = 0; j < 4; ++j)
#pragma unroll
                for (int h = 0; h < 2; ++h) { const int c = LNC(j) + 4 * h; const f32x4 s1 = *(const f32x4*)(sc + c); shv[j][h] = *(const f32x4*)(sh + c);
                    scv[j][h].x = 1.f + s1.x; scv[j][h].y = 1.f + s1.y; scv[j][h].z = 1.f + s1.z; scv[j][h].w = 1.f + s1.w; } }
        f32x4 v[4][2]; float s = 0.f;
#pragma unroll
        for (int j = 0; j < 4; ++j) { const u32x4 p = cu[j];
            v[j][0].x = bflo(p.x); v[j][0].y = bfhi(p.x); v[j][0].z = bflo(p.y); v[j][0].w = bfhi(p.y); v[j][1].x = bflo(p.z); v[j][1].y = bfhi(p.z); v[j][1].z = bflo(p.w); v[j][1].w = bfhi(p.w);
#pragma unroll
            for (int h = 0; h < 2; ++h) s += (v[j][h].x + v[j][h].y) + (v[j][h].z + v[j][h].w); }
        const float mean = wave_sum(s) * (1.f / D); float s2 = 0.f;
#pragma unroll
        for (int j = 0; j < 4; ++j)
#pragma unroll
            for (int h = 0; h < 2; ++h) { v[j][h].x -= mean; v[j][h].y -= mean; v[j][h].z -= mean; v[j][h].w -= mean; s2 += (v[j][h].x * v[j][h].x + v[j][h].y * v[j][h].y) + (v[j][h].z * v[j][h].z + v[j][h].w * v[j][h].w); }
        const float rstd = rsqrtf(wave_sum(s2) * (1.f / D) + LN_EPS);
#pragma unroll
        for (int j = 0; j < 4; ++j) { f32x4 y[2], hh[2];
#pragma unroll
            for (int h = 0; h < 2; ++h) {
                y[h].x = v[j][h].x * rstd * lgv[j][h].x + lbv[j][h].x; y[h].y = v[j][h].y * rstd * lgv[j][h].y + lbv[j][h].y; y[h].z = v[j][h].z * rstd * lgv[j][h].z + lbv[j][h].z; y[h].w = v[j][h].w * rstd * lgv[j][h].w + lbv[j][h].w;
                hh[h].x = y[h].x * scv[j][h].x + shv[j][h].x; hh[h].y = y[h].y * scv[j][h].y + shv[j][h].y; hh[h].z = y[h].z * scv[j][h].z + shv[j][h].z; hh[h].w = y[h].w * scv[j][h].w + shv[j][h].w; }
            st_bf16x8(X1 + (size_t)r * D + LNC(j), y[0], y[1]);
            { u32x2 o8; o8.x = pk4_f8(hh[0].x, hh[0].y, hh[0].z, hh[0].w); o8.y = pk4_f8(hh[1].x, hh[1].y, hh[1].z, hh[1].w); *(u32x2*)(H8 + (size_t)r * D + LNC(j)) = o8; } }
      }
    }
}
template <bool LAST>
__device__ __forceinline__ void phase_ln_final(Frame& F, const Args& a, int layer, int nrows, const bf16_t* X1, const bf16_t* YBb, bf16_t* X2, bf16_t* H) {
    const unsigned char* YB = (const unsigned char*)YBb;
    const int gw = F.bid * NWAVES + F.wave, NGW = F.G * NWAVES;
    const float* MOD = (const float*)(F.ws + WS_MOD) + (size_t)layer * 17 * 12288;
    const float* lg = a.in[6] + (size_t)(layer * 2 + 1) * D; const float* lb = a.in[7] + (size_t)(layer * 2 + 1) * D;
    const int* RT = (const int*)(F.ws + WS_ROUTE);
    const int rpw = (nrows + NGW - 1) / NGW, r0 = gw * rpw, r1 = (r0 + rpw < nrows) ? r0 + rpw : nrows;
    f32x4 lgv[4][2], lbv[4][2], gtv[4][2]; int cur = -1;
#pragma unroll
    for (int j = 0; j < 4; ++j)
#pragma unroll
        for (int h = 0; h < 2; ++h) { lgv[j][h] = *(const f32x4*)(lg + LNC(j) + 4 * h); lbv[j][h] = *(const f32x4*)(lb + LNC(j) + 4 * h); }
    const int r1s = __builtin_amdgcn_readfirstlane(r1);
    for (int rb = __builtin_amdgcn_readfirstlane(r0); rb < r1s; rb += 2) {
        int p0[2], p1[2]; float w0[2], w1[2]; u32x4 qx[2][4]; u32x2 qa[2][4], qb[2][4];
#pragma unroll
        for (int u = 0; u < 2; ++u) { const int r = (rb + u < r1s) ? rb + u : rb;
            p0[u] = RT[(size_t)r * 4 + 0]; p1[u] = RT[(size_t)r * 4 + 1]; w0[u] = __int_as_float(RT[(size_t)r * 4 + 2]); w1[u] = __int_as_float(RT[(size_t)r * 4 + 3]); }
#pragma unroll
        for (int u = 0; u < 2; ++u) { const int r = (rb + u < r1s) ? rb + u : rb;
#pragma unroll
            for (int j = 0; j < 4; ++j) { qx[u][j] = NTL((const u32x4*)(X1 + (size_t)r * D + LNC(j))); qa[u][j] = NTL((const u32x2*)(YB + (size_t)p0[u] * D + LNC(j))); qb[u][j] = NTL((const u32x2*)(YB + (size_t)p1[u] * D + LNC(j))); } }
#pragma unroll
        for (int u = 0; u < 2; ++u) { const int r = rb + u; if (r >= r1s) break;
        const int mr = r < TL ? (r >> 11) : 16;
        if (mr != cur) { cur = mr; const float* gt = MOD + (size_t)mr * 12288 + 5 * 2048;
#pragma unroll
            for (int j = 0; j < 4; ++j) { gtv[j][0] = *(const f32x4*)(gt + LNC(j)); gtv[j][1] = *(const f32x4*)(gt + LNC(j) + 4); } }
        const float ww0 = w0[u], ww1 = w1[u];
        f32x4 v[4][2]; float s = 0.f;
#pragma unroll
        for (int j = 0; j < 4; ++j) { float xx[8], ya[8], yb[8];
            unpack8(qx[u][j], xx); unpack8_f8(qa[u][j], ya); unpack8_f8(qb[u][j], yb);
#pragma unroll
            for (int h = 0; h < 2; ++h) { const f32x4 g4 = gtv[j][h];
                v[j][h].x = ALPHA * xx[4 * h + 0] + g4.x * (ww0 * ya[4 * h + 0] + ww1 * yb[4 * h + 0]);
                v[j][h].y = ALPHA * xx[4 * h + 1] + g4.y * (ww0 * ya[4 * h + 1] + ww1 * yb[4 * h + 1]);
                v[j][h].z = ALPHA * xx[4 * h + 2] + g4.z * (ww0 * ya[4 * h + 2] + ww1 * yb[4 * h + 2]);
                v[j][h].w = ALPHA * xx[4 * h + 3] + g4.w * (ww0 * ya[4 * h + 3] + ww1 * yb[4 * h + 3]);
                s += (v[j][h].x + v[j][h].y) + (v[j][h].z + v[j][h].w); } }
        const float mean = wave_sum(s) * (1.f / D); float s2 = 0.f;
#pragma unroll
        for (int j = 0; j < 4; ++j)
#pragma unroll
            for (int h = 0; h < 2; ++h) { v[j][h].x -= mean; v[j][h].y -= mean; v[j][h].z -= mean; v[j][h].w -= mean; s2 += (v[j][h].x * v[j][h].x + v[j][h].y * v[j][h].y) + (v[j][h].z * v[j][h].z + v[j][h].w * v[j][h].w); }
        const float rstd = rsqrtf(wave_sum(s2) * (1.f / D) + LN_EPS);
#pragma unroll
        for (int j = 0; j < 4; ++j) { f32x4 y[2];
#pragma unroll
            for (int h = 0; h < 2; ++h) { y[h].x = v[j][h].x * rstd * lgv[j][h].x + lbv[j][h].x; y[h].y = v[j][h].y * rstd * lgv[j][h].y + lbv[j][h].y; y[h].z = v[j][h].z * rstd * lgv[j][h].z + lbv[j][h].z; y[h].w = v[j][h].w * rstd * lgv[j][h].w + lbv[j][h].w; }
            if (LAST) { NTS(y[0], (f32x4*)(F.out + (size_t)r * D + LNC(j))); NTS(y[1], (f32x4*)(F.out + (size_t)r * D + LNC(j) + 4)); }
            else st_bf16x8(X2 + (size_t)r * D + LNC(j), y[0], y[1]); }
        }
    }
}

__device__ __forceinline__ void phase_ssd_scan(Frame& F, const Args& a) {
    const bf16_t* XC = (const bf16_t*)(F.ws + WSLOT(3)); const float* DT = (const float*)(F.ws + WS_DT);
    bf16_t* Y = (bf16_t*)(F.ws + WSLOT(4));
    LAS bf16_t* xs = (LAS bf16_t*)F.lds;
    LAS bf16_t* Bs = (LAS bf16_t*)(F.lds + 8192);
    LAS bf16_t* Cs = (LAS bf16_t*)(F.lds + 16384);
    LAS float* dts = (LAS float*)(F.lds + 24576);
    LAS float* ybuf = (LAS float*)(F.lds + 32768);
    const int t = F.tid, team = t >> 8, tt = t & 255, pi = tt >> 4, ni = tt & 15;
    const int si = t >> 4, sp = t & 15;
    for (int unit = F.bid; unit < 256; unit += F.G) {
        const int b = unit >> 4, dir = (unit >> 3) & 1, hp = unit & 7, g = hp >> 2, h = 2 * hp + team;
        const float Ah = -__expf(a.in[11][dir * 16 + h]);
        float S[4][8];
#pragma unroll
        for (int j = 0; j < 4; ++j)
#pragma unroll
            for (int i = 0; i < 8; ++i) S[j][i] = 0.f;
        u32x4 px, pb, pc; float pdt = 0.f;
        auto load_chunk = [&](int chunk) {
            int L, base, c0; if (chunk < 8) { L = CTXL; base = TL + b * CTXL; c0 = chunk * 32; } else { L = SEQ; base = b * SEQ; c0 = (chunk - 8) * 32; }
            const int s = c0 + si; const size_t row = (size_t)(base + (dir ? (L - 1 - s) : s));
            px = *(const u32x4*)(XC + row * 1536 + hp * 128 + sp * 8);
            pb = *(const u32x4*)(XC + row * 1536 + 1024 + g * 128 + sp * 8);
            pc = *(const u32x4*)(XC + row * 1536 + 1280 + g * 128 + sp * 8);
            if (t < 64) { const int i2 = t >> 1, hh = t & 1; const int s2 = c0 + i2; const size_t row2 = (size_t)(base + (dir ? (L - 1 - s2) : s2)); pdt = DT[row2 * 32 + dir * 16 + 2 * hp + hh]; }
        };
        load_chunk(0);
        for (int chunk = 0; chunk < 72; ++chunk) {
            __syncthreads();
            *(LAS u32x4*)(xs + si * 128 + sp * 8) = px; *(LAS u32x4*)(Bs + si * 128 + sp * 8) = pb; *(LAS u32x4*)(Cs + si * 128 + sp * 8) = pc;
            if (t < 64) dts[t] = pdt;
            __syncthreads();
            if (chunk + 1 < 72) load_chunk(chunk + 1);
#pragma unroll 2
            for (int s = 0; s < 32; ++s) {
                const float dtv = dts[s * 2 + team]; const float dec = __expf(dtv * Ah);
                const u32x2 xr = *(const LAS u32x2*)(xs + s * 128 + team * 64 + pi * 4);
                float Bv[8], Cv[8]; unpack8(*(const LAS u32x4*)(Bs + s * 128 + ni * 8), Bv); unpack8(*(const LAS u32x4*)(Cs + s * 128 + ni * 8), Cv);
                float xv[4]; xv[0] = bflo(xr.x) * dtv; xv[1] = bfhi(xr.x) * dtv; xv[2] = bflo(xr.y) * dtv; xv[3] = bfhi(xr.y) * dtv;
                float yp[4];
#pragma unroll
                for (int j = 0; j < 4; ++j) { float acc = 0.f;
#pragma unroll
                    for (int i = 0; i < 8; ++i) { S[j][i] = fmaf(xv[j], Bv[i], S[j][i] * dec); acc = fmaf(S[j][i], Cv[i], acc); }
                    yp[j] = row16_sum(acc); }
                const float ysel = ni == 0 ? yp[0] : (ni == 1 ? yp[1] : (ni == 2 ? yp[2] : yp[3]));
                if (ni < 4) ybuf[s * 128 + team * 64 + pi * 4 + ni] = ysel;
            }
            __syncthreads();
            {   int L, base, c0; if (chunk < 8) { L = CTXL; base = TL + b * CTXL; c0 = chunk * 32; } else { L = SEQ; base = b * SEQ; c0 = (chunk - 8) * 32; }
                const int s = c0 + si; const size_t row = (size_t)(base + (dir ? (L - 1 - s) : s));
                float o[8];
#pragma unroll
                for (int q = 0; q < 8; ++q) o[q] = ybuf[si * 128 + sp * 8 + q];
                *(u32x4*)(Y + (size_t)dir * T * 1024 + row * 1024 + hp * 128 + sp * 8) = pack8(o); }
        }
        __syncthreads();
    }
}


constexpr int LD_N = 136, LD_S = 72;
constexpr int SS_CM = 0;
constexpr int SS_BM = SS_CM + 64 * LD_N * 2;
constexpr int SS_BT = SS_BM + 64 * LD_N * 2;
constexpr int SS_XD = SS_BT + 128 * LD_S * 2;
constexpr int SS_XW = SS_XD + 128 * LD_S * 2;
constexpr int SS_MH = SS_XW + 128 * LD_S * 2;
constexpr int SS_SB = SS_MH + 128 * LD_S * 2;
constexpr int SS_DT = SS_SB + 128 * LD_N * 2;
constexpr int SS_AC = SS_DT + 512;
static_assert(SS_AC + 512 <= LDS_MISC, "SSD scratch overlaps the misc words");

__device__ __forceinline__ void mfma_settle(f32x4& a, f32x4& b, f32x4& c, f32x4& d) { asm volatile("s_nop 7\n\ts_nop 7" : "+v"(a), "+v"(b), "+v"(c), "+v"(d)); }
__device__ __forceinline__ bf16x8 ldfrag(const LAS bf16_t* P, int ld, int fr, int fq, int k) { return *(const LAS bf16x8*)(P + fr * ld + k * 32 + fq * 8); }
#define MFMA16(a_, b_, c_) __builtin_amdgcn_mfma_f32_16x16x32_bf16((a_), (b_), (c_), 0, 0, 0)
template <int KSTEPS>
__device__ __forceinline__ f32x4 mma16(const LAS bf16_t* A, int lda, const LAS bf16_t* Bt, int ldb, f32x4 acc, int fr, int fq) {
#pragma unroll
    for (int k = 0; k < KSTEPS; ++k) {
        const bf16x8 av = *(const LAS bf16x8*)(A + fr * lda + k * 32 + fq * 8);
        const bf16x8 bv = *(const LAS bf16x8*)(Bt + fr * ldb + k * 32 + fq * 8);
        acc = __builtin_amdgcn_mfma_f32_16x16x32_bf16(av, bv, acc, 0, 0, 0);
    }
    return acc;
}

__device__ __forceinline__ void phase_ssd_chunked(Frame& F, const Args& a) {
    const bf16_t* XC = (const bf16_t*)(F.ws + WSLOT(3)); const float* DT = (const float*)(F.ws + WS_DT);
    bf16_t* Y = (bf16_t*)(F.ws + WSLOT(4));
    LAS bf16_t* Cm = (LAS bf16_t*)(F.lds + SS_CM); LAS bf16_t* Bm = (LAS bf16_t*)(F.lds + SS_BM); LAS bf16_t* BT = (LAS bf16_t*)(F.lds + SS_BT);
    LAS bf16_t* XdT = (LAS bf16_t*)(F.lds + SS_XD); LAS bf16_t* XwT = (LAS bf16_t*)(F.lds + SS_XW); LAS bf16_t* Mh = (LAS bf16_t*)(F.lds + SS_MH);
    LAS bf16_t* Sb = (LAS bf16_t*)(F.lds + SS_SB); LAS float* dtl = (LAS float*)(F.lds + SS_DT); LAS float* acl = (LAS float*)(F.lds + SS_AC);
    const int t = F.tid, w = F.wave, lane = F.lane, fr = lane & 15, fq = lane >> 4;
    const int j16 = t >> 5, s0 = t & 31;
    const int hh = w >> 2;
    for (int unit = F.bid; unit < 256; unit += F.G) {
        const int b = unit >> 4, dir = (unit >> 3) & 1, hp = unit & 7, g = hp >> 2;
        const float A0 = -__expf(a.in[11][dir * 16 + 2 * hp]), A1 = -__expf(a.in[11][dir * 16 + 2 * hp + 1]);
        f32x4 sacc[2][4];
#pragma unroll
        for (int i = 0; i < 2; ++i)
#pragma unroll
            for (int j = 0; j < 4; ++j) sacc[i][j] = (f32x4){0.f, 0.f, 0.f, 0.f};
        u32x4 pc[2], pb[2], px[2]; float pdt = 0.f;
#define SSD_LOAD(chunk_) do { int L_, base_, c0_; if ((chunk_) < 4) { L_ = CTXL; base_ = TL + b * CTXL; c0_ = (chunk_) * 64; } else { L_ = SEQ; base_ = b * SEQ; c0_ = ((chunk_) - 4) * 64; } \
            _Pragma("unroll") for (int hf = 0; hf < 2; ++hf) { const int s_ = c0_ + s0 + 32 * hf; const size_t row_ = (size_t)(base_ + (dir ? (L_ - 1 - s_) : s_)); \
                pc[hf] = *(const u32x4*)(XC + row_ * 1536 + 1280 + g * 128 + 8 * j16); pb[hf] = *(const u32x4*)(XC + row_ * 1536 + 1024 + g * 128 + 8 * j16); \
                px[hf] = *(const u32x4*)(XC + row_ * 1536 + hp * 128 + 8 * j16); } \
            if (t < 128) { const int s_ = c0_ + (t & 63); const size_t row_ = (size_t)(base_ + (dir ? (L_ - 1 - s_) : s_)); pdt = DT[row_ * 32 + dir * 16 + 2 * hp + (t >> 6)]; } } while (0)
        SSD_LOAD(0);
        for (int chunk = 0; chunk < 36; ++chunk) {
            __syncthreads();
            mfma_settle(sacc[0][0], sacc[0][1], sacc[0][2], sacc[0][3]); mfma_settle(sacc[1][0], sacc[1][1], sacc[1][2], sacc[1][3]);
#pragma unroll
            for (int i = 0; i < 2; ++i)
#pragma unroll
                for (int j = 0; j < 4; ++j) { const int n0 = 16 * (2 * (w & 3) + i) + 4 * fq, p = 16 * j + fr;
                    u32x2 o; o.x = pk2(sacc[i][j].x, sacc[i][j].y); o.y = pk2(sacc[i][j].z, sacc[i][j].w);
                    *(LAS u32x2*)(Sb + (hh * 64 + p) * LD_N + n0) = o; }
#pragma unroll
            for (int hf = 0; hf < 2; ++hf) { const int s = s0 + 32 * hf;
                *(LAS u32x4*)(Cm + s * LD_N + 8 * j16) = pc[hf]; *(LAS u32x4*)(Bm + s * LD_N + 8 * j16) = pb[hf];
                const unsigned bw[4] = {pb[hf].x, pb[hf].y, pb[hf].z, pb[hf].w};
#pragma unroll
                for (int x = 0; x < 4; ++x) { BT[(8 * j16 + 2 * x) * LD_S + s] = (bf16_t)(bw[x] & 0xffffu); BT[(8 * j16 + 2 * x + 1) * LD_S + s] = (bf16_t)(bw[x] >> 16); } }
            if (w < 2) { float v = pdt * (w ? A1 : A0);
#pragma unroll
                for (int o = 1; o < 64; o <<= 1) { const float u = __shfl_up(v, o); if (lane >= o) v += u; }
                dtl[w * 64 + lane] = pdt; acl[w * 64 + lane] = v; }
            __syncthreads();
#pragma unroll
            for (int hf = 0; hf < 2; ++hf) { const int s = s0 + 32 * hf, xh = j16 >> 3, pbase = (j16 & 7) * 8;
                const float dtv = dtl[xh * 64 + s], fw = __expf(acl[xh * 64 + 63] - acl[xh * 64 + s]);
                float xv[8]; unpack8(px[hf], xv);
#pragma unroll
                for (int x = 0; x < 8; ++x) { const float xd = xv[x] * dtv; const unsigned pkd = pk2(xd, xd * fw);
                    XdT[(xh * 64 + pbase + x) * LD_S + s] = (bf16_t)(pkd & 0xffffu); XwT[(xh * 64 + pbase + x) * LD_S + s] = (bf16_t)(pkd >> 16); } }
            if (chunk + 1 < 36) SSD_LOAD(chunk + 1);
            __syncthreads();
            {   const int st = w >> 1;
#pragma unroll
                for (int q = 0; q < 2; ++q) { const int lt = 2 * (w & 1) + q;
                    const f32x4 gv = mma16<4>(Bm + 16 * st * LD_N, LD_N, Cm + 16 * lt * LD_N, LD_N, (f32x4){0.f, 0.f, 0.f, 0.f}, fr, fq);
                    const int l = 16 * lt + fr, sb = 16 * st + 4 * fq;
#pragma unroll
                    for (int h2 = 0; h2 < 2; ++h2) { const float al = acl[h2 * 64 + l];
                        const float m0 = (sb + 0 <= l) ? gv.x * __expf(al - acl[h2 * 64 + sb + 0]) : 0.f;
                        const float m1 = (sb + 1 <= l) ? gv.y * __expf(al - acl[h2 * 64 + sb + 1]) : 0.f;
                        const float m2 = (sb + 2 <= l) ? gv.z * __expf(al - acl[h2 * 64 + sb + 2]) : 0.f;
                        const float m3 = (sb + 3 <= l) ? gv.w * __expf(al - acl[h2 * 64 + sb + 3]) : 0.f;
                        u32x2 o; o.x = pk2(m0, m1); o.y = pk2(m2, m3);
                        *(LAS u32x2*)(Mh + (h2 * 64 + l) * LD_S + sb) = o; } } }
            __syncthreads();
            {   const int lt = w & 3;
                f32x4 yacc[4];
#pragma unroll
                for (int pt = 0; pt < 4; ++pt) yacc[pt] = mma16<4>(Sb + (hh * 64 + 16 * pt) * LD_N, LD_N, Cm + 16 * lt * LD_N, LD_N, (f32x4){0.f, 0.f, 0.f, 0.f}, fr, fq);
                const float el = __expf(acl[hh * 64 + 16 * lt + fr]);
#pragma unroll
                for (int pt = 0; pt < 4; ++pt) { yacc[pt].x *= el; yacc[pt].y *= el; yacc[pt].z *= el; yacc[pt].w *= el;
                    yacc[pt] = mma16<2>(XdT + (hh * 64 + 16 * pt) * LD_S, LD_S, Mh + (hh * 64 + 16 * lt) * LD_S, LD_S, yacc[pt], fr, fq); }
                int L, base, c0; if (chunk < 4) { L = CTXL; base = TL + b * CTXL; c0 = chunk * 64; } else { L = SEQ; base = b * SEQ; c0 = (chunk - 4) * 64; }
                const int sidx = c0 + 16 * lt + fr; const size_t row = (size_t)(base + (dir ? (L - 1 - sidx) : sidx));
                bf16_t* Yd = Y + (size_t)dir * T * 1024 + (2 * hp + hh) * 64 + 4 * fq + row * 1024;
#pragma unroll
                for (int pt = 0; pt < 4; ++pt) { u32x2 o; o.x = pk2(yacc[pt].x, yacc[pt].y); o.y = pk2(yacc[pt].z, yacc[pt].w); *(u32x2*)(Yd + 16 * pt) = o; } }
            {   const float cd = __expf(acl[hh * 64 + 63]);
#pragma unroll
                for (int i = 0; i < 2; ++i)
#pragma unroll
                    for (int j = 0; j < 4; ++j) { sacc[i][j].x *= cd; sacc[i][j].y *= cd; sacc[i][j].z *= cd; sacc[i][j].w *= cd;
                        sacc[i][j] = mma16<2>(BT + 16 * (2 * (w & 3) + i) * LD_S, LD_S, XwT + (hh * 64 + 16 * j) * LD_S, LD_S, sacc[i][j], fr, fq); } }
        }
#undef SSD_LOAD
        __syncthreads();
    }
}

__device__ __forceinline__ void phase_route_count(Frame& F, const Args& a, int t0, int per, int ntok, unsigned* gcnt) {
    const float* LG = (const float*)(F.ws + WS_LOGIT); int* RT = (int*)(F.ws + WS_ROUTE); const float* bias = a.in[33];
    {   int* TOK = (int*)(F.ws + WS_TOK); for (int i = F.bid * NTHREADS + F.tid; i < 81920; i += F.G * NTHREADS) TOK[i] = 0; }
    LAS int* lcnt = (LAS int*)(F.lds); LAS int* lbase = lcnt + 32;
    const int tok = t0 + F.tid; const bool act = F.tid < per && tok < ntok;
    if (F.tid < 32) lcnt[F.tid] = 0;
    __syncthreads();
    int e0 = 0, e1 = 0, r0 = 0, r1 = 0; float w0 = 0.f, w1 = 0.f;
    if (act) {
        float s[32], ss[32];
#pragma unroll
        for (int q = 0; q < 8; ++q) { const f32x4 v = *(const f32x4*)(LG + (size_t)tok * 32 + 4 * q); s[4 * q] = sigmoidf_(v.x); s[4 * q + 1] = sigmoidf_(v.y); s[4 * q + 2] = sigmoidf_(v.z); s[4 * q + 3] = sigmoidf_(v.w); }
#pragma unroll
        for (int q = 0; q < 32; ++q) ss[q] = s[q] + bias[q];
        float best = -3.0e38f; int gsel = 0;
#pragma unroll
        for (int g = 0; g < 4; ++g) { float m1 = -3.0e38f, m2 = -3.0e38f;
#pragma unroll
            for (int q = 0; q < 8; ++q) { const float v = ss[g * 8 + q]; if (v > m1) { m2 = m1; m1 = v; } else if (v > m2) m2 = v; }
            const float gs = m1 + m2; if (gs > best) { best = gs; gsel = g; } }
        float m1 = -3.0e38f, m2 = -3.0e38f; int i1 = 0, i2 = 0; float s1 = 0.f, s2 = 0.f;
#pragma unroll
        for (int g = 0; g < 4; ++g)
#pragma unroll
            for (int q = 0; q < 8; ++q) { if (g == gsel) { const float v = ss[g * 8 + q]; const float sv = s[g * 8 + q];
                if (v > m1) { m2 = m1; i2 = i1; s2 = s1; m1 = v; i1 = g * 8 + q; s1 = sv; } else if (v > m2) { m2 = v; i2 = g * 8 + q; s2 = sv; } } }
        e0 = i1; e1 = i2; const float inv = 1.f / (s1 + s2); w0 = s1 * inv; w1 = s2 * inv;
        r0 = atomicAdd((int*)&lcnt[e0], 1); r1 = atomicAdd((int*)&lcnt[e1], 1);
    }
    __syncthreads();
    if (F.tid < 32) lbase[F.tid] = (int)atomicAdd(&gcnt[F.tid], (unsigned)lcnt[F.tid]);
    __syncthreads();
    if (act) { RT[(size_t)tok * 4 + 0] = (e0 << 24) | (lbase[e0] + r0); RT[(size_t)tok * 4 + 1] = (e1 << 24) | (lbase[e1] + r1);
        RT[(size_t)tok * 4 + 2] = __float_as_int(w0); RT[(size_t)tok * 4 + 3] = __float_as_int(w1); }
}
__device__ __forceinline__ void moe_tables(Frame& F, const unsigned* gcnt) {
    LAS int* tstart = (LAS int*)(F.lds + LDS_MISC + 256);
    if (F.tid == 0) { int acc = 0;
        for (int e = 0; e < 32; ++e) { tstart[e] = acc; const int c = (int)__hip_atomic_load(&gcnt[e], __ATOMIC_RELAXED, __HIP_MEMORY_SCOPE_AGENT); acc += (c + 255) >> 8; }
        tstart[32] = acc; }
    __syncthreads();
}
__device__ __forceinline__ void phase_route_scatter(Frame& F, int ntok, const unsigned* gcnt) {
    moe_tables(F, gcnt);
    const LAS int* tstart = (const LAS int*)(F.lds + LDS_MISC + 256);
    int* RT = (int*)(F.ws + WS_ROUTE); int* TOK = (int*)(F.ws + WS_TOK);
    for (int tok = F.bid * NTHREADS + F.tid; tok < ntok; tok += F.G * NTHREADS) {
        const int v0 = RT[(size_t)tok * 4 + 0], v1 = RT[(size_t)tok * 4 + 1];
        const int p0 = tstart[(v0 >> 24) & 31] * 256 + (v0 & 0xffffff), p1 = tstart[(v1 >> 24) & 31] * 256 + (v1 & 0xffffff);
        TOK[p0] = tok; TOK[p1] = tok; RT[(size_t)tok * 4 + 0] = p0; RT[(size_t)tok * 4 + 1] = p1;
    }
}

__device__ __forceinline__ void phase_mixes6(Frame& F, const Args& a, const bf16_t* X2, unsigned char* OB) {
    const size_t gt = (size_t)F.bid * NTHREADS + F.tid, NGT = (size_t)F.G * NTHREADS;
    const float* mu = a.in[16];
    const float* MOD1 = (const float*)(F.ws + WS_MOD) + (size_t)17 * 12288;
    const int c = (int)(gt & 255) * 8, q = __builtin_amdgcn_readfirstlane(c >> 9);
    float m[6][8], sc8[8], sh8[8]; int cur = -1;
    constexpr int MUI[6] = {0, 2, 3, 1, 4, 5};
#pragma unroll
    for (int i = 0; i < 6; ++i)
#pragma unroll
        for (int x = 0; x < 8; ++x) m[i][x] = mu[MUI[i] * D + c + x];
    for (size_t base0 = (size_t)F.bid * NTHREADS; base0 < (size_t)T * 256; base0 += 4 * NGT) {
        u32x4 hq[4], nq[4]; int rr[4];
#pragma unroll
        for (int u = 0; u < 4; ++u) { const size_t base = base0 + (size_t)u * NGT; rr[u] = -1; hq[u] = (u32x4){0u, 0u, 0u, 0u}; nq[u] = (u32x4){0u, 0u, 0u, 0u};
            if (base < (size_t)T * 256) { const int r = __builtin_amdgcn_readfirstlane((int)((base + F.tid) >> 8)); rr[u] = r;
                int nb = -1;
                if (r < TL) { const int l = r & 2047;
                    if (q == 0) { if ((l & 63) >= 1) nb = r - 1; } else if (q == 1) { if ((l & 63) <= 62) nb = r + 1; }
                    else if (q == 2) { if (l >= 64) nb = r - 64; } else { if (l < SEQ - 64) nb = r + 64; } }
                else { const int l = (r - TL) & 255;
                    if (q == 0 || q == 2) { if (l >= 1) nb = r - 1; } else { if (l <= CTXL - 2) nb = r + 1; } }
                hq[u] = *(const u32x4*)(X2 + (size_t)r * D + c);
                nq[u] = *(const u32x4*)(X2 + (size_t)(nb >= 0 ? nb : r) * D + c);
                if (nb < 0) rr[u] |= 0x40000000; } }
#pragma unroll
        for (int u = 0; u < 4; ++u) { if (rr[u] < 0) continue;
            const int r = rr[u] & 0x3fffffff; const bool has_nb = !(rr[u] & 0x40000000);
            const int mr = r < TL ? (r >> 11) : 16;
            if (mr != cur) { cur = mr; const float* sh = MOD1 + (size_t)mr * 12288 + c; const float* sc = sh + 2048;
                const f32x4 a0 = *(const f32x4*)sh, a1 = *(const f32x4*)(sh + 4), b0 = *(const f32x4*)sc, b1 = *(const f32x4*)(sc + 4);
                sh8[0] = a0.x; sh8[1] = a0.y; sh8[2] = a0.z; sh8[3] = a0.w; sh8[4] = a1.x; sh8[5] = a1.y; sh8[6] = a1.z; sh8[7] = a1.w;
                sc8[0] = 1.f + b0.x; sc8[1] = 1.f + b0.y; sc8[2] = 1.f + b0.z; sc8[3] = 1.f + b0.w; sc8[4] = 1.f + b1.x; sc8[5] = 1.f + b1.y; sc8[6] = 1.f + b1.z; sc8[7] = 1.f + b1.w; }
            float h[8], hn[8];
            unpack8(hq[u], h); unpack8(nq[u], hn);
#pragma unroll
            for (int x = 0; x < 8; ++x) { h[x] = h[x] * sc8[x] + sh8[x]; hn[x] = has_nb ? (hn[x] * sc8[x] + sh8[x] - h[x]) : -h[x]; }
#pragma unroll
            for (int i = 0; i < 6; ++i) { float o[8];
#pragma unroll
                for (int x = 0; x < 8; ++x) o[x] = h[x] + hn[x] * m[i][x];
                u32x2 p; p.x = pk4_f8(o[0], o[1], o[2], o[3]); p.y = pk4_f8(o[4], o[5], o[6], o[7]);
                *(u32x2*)(OB + (size_t)(i % 3) * SLOT + (size_t)(i / 3) * T * D + (size_t)r * D + c) = p; } }
    }
}
__device__ __forceinline__ void phase_kknorm(Frame& F, const Args& a, const bf16_t* Kb) {
    const int gw = F.bid * NWAVES + F.wave, NGW = F.G * NWAVES;
    float* INVN = (float*)(F.ws + WS_INVN); const float* kk_c = a.in[27];
    float kkv[4][8];
#pragma unroll
    for (int j = 0; j < 4; ++j)
#pragma unroll
        for (int x = 0; x < 8; ++x) kkv[j][x] = kk_c[8 * F.lane + 512 * j + x];
    for (int r = gw; r < T; r += NGW) {
#pragma unroll
        for (int j = 0; j < 4; ++j) { const int c = 8 * F.lane + 512 * j; float k[8]; unpack8(*(const u32x4*)(Kb + (size_t)r * D + c), k); float ss = 0.f;
#pragma unroll
            for (int x = 0; x < 8; ++x) { const float v = k[x] * kkv[j][x]; ss += v * v; }
            ss = grp8_sum(ss);
            if ((F.lane & 7) == 0) INVN[(size_t)r * 32 + (c >> 6)] = 1.f / fmaxf(sqrtf(ss), 1e-12f); }
    }
}
template <bool WRITE>
__device__ __forceinline__ void phase_wkv_scan(Frame& F, const Args& a, const bf16_t* Rb, const bf16_t* Kb, const bf16_t* Vb, const bf16_t* Q0, const bf16_t* Q1, bf16_t* A0, bf16_t* A1) {
    LAS float* st = (LAS float*)F.lds;
    LAS float* ybuf = (LAS float*)(F.lds + 98304);
    const float* INVN = (const float*)(F.ws + WS_INVN);
    const int t = F.tid, w = F.wave, hh = w >> 1, half = w & 1, i = F.lane >> 3, jj = F.lane & 7;
    const int sst = t >> 5, cg = t & 31, hs = cg >> 3, cs = (cg & 7) * 8;
    for (int unit = F.bid; unit < 256; unit += F.G) {
        const int e = unit >> 7, b = (unit >> 3) & 15, j4 = unit & 7, col0 = j4 * 256;
        const bf16_t* Qe = e ? +Q1 : +Q0; bf16_t* Ae = e ? +A1 : +A0;
        float kkc[8], kac[8], w0c[8], a0c[8];
#pragma unroll
        for (int x = 0; x < 8; ++x) { kkc[x] = a.in[27][col0 + cg * 8 + x]; kac[x] = a.in[28][col0 + cg * 8 + x];
            w0c[x] = a.in[19][e * D + col0 + cg * 8 + x]; a0c[x] = a.in[22][e * D + col0 + cg * 8 + x]; }
        float S[4][8];
#pragma unroll
        for (int j = 0; j < 4; ++j)
#pragma unroll
            for (int x = 0; x < 8; ++x) S[j][x] = 0.f;
        u32x4 pr, pk, pv, pq, pa; float pin = 0.f; size_t prow = 0;
        auto load_chunk = [&](int ci) {
            int L, base, s0; if (ci < 16) { L = CTXL; base = TL + b * CTXL; s0 = ci * 16; } else { L = SEQ; base = b * SEQ; s0 = (ci - 16) * 16; }
            const int s = s0 + sst; const size_t row = (size_t)(base + (e ? (L - 1 - s) : s)); const size_t off = row * D + col0 + cg * 8;
            pr = *(const u32x4*)(Rb + off); pk = *(const u32x4*)(Kb + off); pv = *(const u32x4*)(Vb + off); pq = *(const u32x4*)(Qe + off); pa = *(const u32x4*)(Ae + off);
            pin = INVN[row * 32 + j4 * 4 + hs]; prow = row;
        };
        load_chunk(0);
        for (int ci = 0; ci < 144; ++ci) {
            __syncthreads();
            const size_t crow = prow;
            {   float r8[8], k8[8], v8[8], q8[8], a8[8]; unpack8(pr, r8); unpack8(pk, k8); unpack8(pv, v8); unpack8(pq, q8); unpack8(pa, a8);
                float kk8[8], w8[8], b8[8], kd8[8];
#pragma unroll
                for (int x = 0; x < 8; ++x) { kk8[x] = k8[x] * kkc[x] * pin;
                    w8[x] = __expf(-0.6065306597f * sigmoidf_(w0c[x] + q8[x]));
                    const float av = sigmoidf_(a0c[x] + a8[x]);
                    b8[x] = kk8[x] * av; kd8[x] = k8[x] * (1.f + (av - 1.f) * kac[x]); }
                LAS float* dst = st + ((sst * 4 + hs) * 6) * 64 + cs;
                *(LAS f32x4*)(dst + 0 * 64) = (f32x4){r8[0], r8[1], r8[2], r8[3]};   *(LAS f32x4*)(dst + 0 * 64 + 4) = (f32x4){r8[4], r8[5], r8[6], r8[7]};
                *(LAS f32x4*)(dst + 1 * 64) = (f32x4){kk8[0], kk8[1], kk8[2], kk8[3]}; *(LAS f32x4*)(dst + 1 * 64 + 4) = (f32x4){kk8[4], kk8[5], kk8[6], kk8[7]};
                *(LAS f32x4*)(dst + 2 * 64) = (f32x4){w8[0], w8[1], w8[2], w8[3]};   *(LAS f32x4*)(dst + 2 * 64 + 4) = (f32x4){w8[4], w8[5], w8[6], w8[7]};
                *(LAS f32x4*)(dst + 3 * 64) = (f32x4){b8[0], b8[1], b8[2], b8[3]};   *(LAS f32x4*)(dst + 3 * 64 + 4) = (f32x4){b8[4], b8[5], b8[6], b8[7]};
                *(LAS f32x4*)(dst + 4 * 64) = (f32x4){kd8[0], kd8[1], kd8[2], kd8[3]}; *(LAS f32x4*)(dst + 4 * 64 + 4) = (f32x4){kd8[4], kd8[5], kd8[6], kd8[7]};
                *(LAS f32x4*)(dst + 5 * 64) = (f32x4){v8[0], v8[1], v8[2], v8[3]};   *(LAS f32x4*)(dst + 5 * 64 + 4) = (f32x4){v8[4], v8[5], v8[6], v8[7]}; }
            __syncthreads();
            if (ci + 1 < 144) load_chunk(ci + 1);
#pragma unroll 2
            for (int s = 0; s < 16; ++s) {
                const LAS float* p = st + ((s * 4 + hh) * 6) * 64 + jj * 8;
                const f32x4 r0 = *(const LAS f32x4*)(p), r1 = *(const LAS f32x4*)(p + 4);
                const f32x4 k0 = *(const LAS f32x4*)(p + 64), k1 = *(const LAS f32x4*)(p + 68);
                const f32x4 w0 = *(const LAS f32x4*)(p + 128), w1 = *(const LAS f32x4*)(p + 132);
                const f32x4 b0 = *(const LAS f32x4*)(p + 192), b1 = *(const LAS f32x4*)(p + 196);
                const f32x4 d0 = *(const LAS f32x4*)(p + 256), d1 = *(const LAS f32x4*)(p + 260);
                const f32x4 vv = *(const LAS f32x4*)(st + ((s * 4 + hh) * 6 + 5) * 64 + half * 32 + i * 4);
                const float rr[8] = {r0.x, r0.y, r0.z, r0.w, r1.x, r1.y, r1.z, r1.w}, kk[8] = {k0.x, k0.y, k0.z, k0.w, k1.x, k1.y, k1.z, k1.w};
                const float ww[8] = {w0.x, w0.y, w0.z, w0.w, w1.x, w1.y, w1.z, w1.w}, bb[8] = {b0.x, b0.y, b0.z, b0.w, b1.x, b1.y, b1.z, b1.w};
                const float kd[8] = {d0.x, d0.y, d0.z, d0.w, d1.x, d1.y, d1.z, d1.w}, vr[4] = {vv.x, vv.y, vv.z, vv.w};
                float yo[4];
#pragma unroll
                for (int j = 0; j < 4; ++j) { float sa = 0.f;
#pragma unroll
                    for (int x = 0; x < 8; ++x) sa = fmaf(S[j][x], kk[x], sa);
                    sa = -row8_sum(sa); float yacc = 0.f;
#pragma unroll
                    for (int x = 0; x < 8; ++x) { S[j][x] = fmaf(vr[j], kd[x], fmaf(sa, bb[x], S[j][x] * ww[x])); yacc = fmaf(S[j][x], rr[x], yacc); }
                    yo[j] = row8_sum(yacc); }
                const float ysel = jj == 0 ? yo[0] : (jj == 1 ? yo[1] : (jj == 2 ? yo[2] : yo[3]));
                if (jj < 4) ybuf[s * 256 + hh * 64 + half * 32 + i * 4 + jj] = ysel;
            }
            __syncthreads();
            if (WRITE && ci >= 16) { float o[8];
#pragma unroll
                for (int x = 0; x < 8; ++x) o[x] = ybuf[sst * 256 + cg * 8 + x];
                *(u32x4*)(Ae + crow * D + col0 + cg * 8) = pack8(o); }
        }
        __syncthreads();
    }
}

constexpr int WK_AT = 0, WK_RT = 2304, WK_BD = 4608, WK_BDT = 9216, WK_PVT = 14336, WK_LM = 19456, WK_LADM = 20736, WK_LAB = 22016, WK_RHS = 23040, WK_WC = 27136, WK_SB = 27392, WK_RAW2 = 36608, WK_HEAD = 40704;
constexpr int WK_RAW1 = WK_LADM;
static_assert(4 * WK_HEAD <= LDS_MISC, "WKV scratch overlaps the misc words");

__device__ __forceinline__ void phase_wkv_chunked(Frame& F, const Args& a, const bf16_t* Rb, const bf16_t* Kb, const bf16_t* Vb, const bf16_t* Q0, const bf16_t* Q1, bf16_t* A0, bf16_t* A1) {
    const int w = F.wave, lane = F.lane, fr = lane & 15, fq = lane >> 4, hh = w & 3, role = w >> 2;
    LAS unsigned char* hb = F.lds + hh * WK_HEAD;
    LAS bf16_t* AT = (LAS bf16_t*)(hb + WK_AT); LAS bf16_t* RT = (LAS bf16_t*)(hb + WK_RT); LAS bf16_t* BD = (LAS bf16_t*)(hb + WK_BD);
    LAS bf16_t* BDT = (LAS bf16_t*)(hb + WK_BDT); LAS bf16_t* PVT = (LAS bf16_t*)(hb + WK_PVT); LAS bf16_t* LM = (LAS bf16_t*)(hb + WK_LM);
    LAS bf16_t* LADM = (LAS bf16_t*)(hb + WK_LADM); LAS float* LABT = (LAS float*)(hb + WK_LAB); LAS float* RHS = (LAS float*)(hb + WK_RHS);
    LAS float* WCa = (LAS float*)(hb + WK_WC); LAS bf16_t* SB = (LAS bf16_t*)(hb + WK_SB);
    LAS bf16_t* RDW = (LAS bf16_t*)(hb + WK_RAW1); LAS bf16_t* RK = RDW + 1024; LAS bf16_t* RR = RDW + 2048; LAS float* RIN = (LAS float*)(hb + WK_RAW1 + 6144);
    LAS bf16_t* RV = (LAS bf16_t*)(hb + WK_RAW2); LAS bf16_t* RA = RV + 1024;
    const int lt = lane >> 3, lc = lane & 7;
    for (int unit = F.bid; unit < 256; unit += F.G) {
        const int e = unit >> 7, b = (unit >> 3) & 15, j4 = unit & 7, cb = j4 * 256 + hh * 64, ch = cb + lane;
        const bf16_t* Qe = e ? +Q1 : +Q0; bf16_t* Ae = e ? +A1 : +A0;
        const float w0c = a.in[19][e * D + ch], a0c = a.in[22][e * D + ch], kkc = a.in[27][ch], kac = a.in[28][ch];
        float kks[8];
        { const f32x4 q0 = *(const f32x4*)(a.in[27] + cb + 8 * lc), q1 = *(const f32x4*)(a.in[27] + cb + 8 * lc + 4); kks[0] = q0.x; kks[1] = q0.y; kks[2] = q0.z; kks[3] = q0.w; kks[4] = q1.x; kks[5] = q1.y; kks[6] = q1.z; kks[7] = q1.w; }
        __syncthreads();
        for (int i = F.tid; i < 4 * WK_HEAD / 16; i += NTHREADS) ((LAS u32x4*)F.lds)[i] = (u32x4){0u, 0u, 0u, 0u};
        f32x4 sacc[2][4];
#pragma unroll
        for (int i = 0; i < 2; ++i)
#pragma unroll
            for (int j = 0; j < 4; ++j) sacc[i][j] = (f32x4){0.f, 0.f, 0.f, 0.f};
        u32x4 g0[2], g1[2], g2[2];
#define WKV_ROW(ci_, tok_) ({ int L_, base_, s0_; if ((ci_) < 16) { L_ = CTXL; base_ = TL + b * CTXL; s0_ = (ci_) * 16; } else { L_ = SEQ; base_ = b * SEQ; s0_ = ((ci_) - 16) * 16; } \
            const int s_ = s0_ + (tok_); (size_t)(base_ + (e ? (L_ - 1 - s_) : s_)); })
#define WKV_LOAD(ci_) do { _Pragma("unroll") for (int j_ = 0; j_ < 2; ++j_) { const size_t off_ = WKV_ROW(ci_, lt + 8 * j_) * D + cb + 8 * lc; \
                if (role == 0) { g0[j_] = *(const u32x4*)(Qe + off_); g1[j_] = *(const u32x4*)(Kb + off_); g2[j_] = *(const u32x4*)(Rb + off_); } \
                else { g0[j_] = *(const u32x4*)(Vb + off_); g1[j_] = *(const u32x4*)(Ae + off_); } } } while (0)
#define WKV_STAGE() do { _Pragma("unroll") for (int j_ = 0; j_ < 2; ++j_) { const int o_ = (lt + 8 * j_) * 64 + 8 * lc; \
                if (role == 0) { float e_[8]; unpack8(g0[j_], e_); _Pragma("unroll") for (int x_ = 0; x_ < 8; ++x_) e_[x_] = 0.6065306597f * sigmoidf_(e_[x_]);     \
                    float k_[8], ss_ = 0.f; unpack8(g1[j_], k_); _Pragma("unroll") for (int x_ = 0; x_ < 8; ++x_) { const float q_ = k_[x_] * kks[x_]; ss_ += q_ * q_; } \
                    ss_ = row8_sum(ss_); if (lc == 0) RIN[lt + 8 * j_] = fminf(__builtin_amdgcn_rsqf(ss_), 1e12f);     \
                    *(LAS u32x4*)(RDW + o_) = pack8(e_); *(LAS u32x4*)(RK + o_) = g1[j_]; *(LAS u32x4*)(RR + o_) = g2[j_]; } \
                else { float a_[8]; unpack8(g1[j_], a_); _Pragma("unroll") for (int x_ = 0; x_ < 8; ++x_) a_[x_] = sigmoidf_(a_[x_]); \
                    *(LAS u32x4*)(RV + o_) = g0[j_]; *(LAS u32x4*)(RA + o_) = pack8(a_); } } } while (0)
        WKV_LOAD(0);
        __syncthreads();
        WKV_STAGE();
        __syncthreads();
        for (int ci = 0; ci < 144; ++ci) {
            if (ci + 1 < 144) WKV_LOAD(ci + 1);
            if (role == 0) {
                float cum = 0.f; unsigned vb[16], xdw[16], xk[16], xr[16]; float xin[16];
#pragma unroll
                for (int t = 0; t < 16; ++t) { xdw[t] = RDW[t * 64 + lane]; xk[t] = RK[t * 64 + lane]; xr[t] = RR[t * 64 + lane]; vb[t] = RV[t * 64 + lane]; }
#pragma unroll
                for (int q = 0; q < 4; ++q) { const f32x4 iv = *(const LAS f32x4*)(RIN + 4 * q); xin[4 * q] = iv.x; xin[4 * q + 1] = iv.y; xin[4 * q + 2] = iv.z; xin[4 * q + 3] = iv.w; }
                asm volatile("s_waitcnt lgkmcnt(0)" ::: "memory");
                float Wc = 1.f;
#pragma unroll
                for (int t = 0; t < 16; ++t) { const float wt = __expf(-bf2f(xdw[t])); const float Wprev = Wc; Wc *= wt;
                    const float kap = bf2f(xk[t]) * kkc * xin[t];
                    const unsigned pkd = pk2(kap * Wprev, bf2f(xr[t]) * Wc);
                    AT[t * 72 + lane] = (bf16_t)(pkd & 0xffffu); RT[t * 72 + lane] = (bf16_t)(pkd >> 16); }
                cum = Wc;
                u32x4 v0, v1;
                v0.x = vb[0] | (vb[1] << 16); v0.y = vb[2] | (vb[3] << 16); v0.z = vb[4] | (vb[5] << 16); v0.w = vb[6] | (vb[7] << 16);
                v1.x = vb[8] | (vb[9] << 16); v1.y = vb[10] | (vb[11] << 16); v1.z = vb[12] | (vb[13] << 16); v1.w = vb[14] | (vb[15] << 16);
                *(LAS u32x4*)(PVT + lane * 40) = v0; *(LAS u32x4*)(PVT + lane * 40 + 8) = v1;
                WCa[lane] = cum;
            } else {
                float cum = 1.f; unsigned dlp[8], btp[8], xdw[16], xk[16], xa[16]; float xin[16];
#pragma unroll
                for (int t = 0; t < 16; ++t) { xdw[t] = RDW[t * 64 + lane]; xk[t] = RK[t * 64 + lane]; xa[t] = RA[t * 64 + lane]; }
#pragma unroll
                for (int q = 0; q < 4; ++q) { const f32x4 iv = *(const LAS f32x4*)(RIN + 4 * q); xin[4 * q] = iv.x; xin[4 * q + 1] = iv.y; xin[4 * q + 2] = iv.z; xin[4 * q + 3] = iv.w; }
                asm volatile("s_waitcnt lgkmcnt(0)" ::: "memory");
#pragma unroll
                for (int t2 = 0; t2 < 8; ++t2) { float dl[2], bt[2];
#pragma unroll
                    for (int q = 0; q < 2; ++q) { const int t = 2 * t2 + q; cum *= __expf(bf2f(xdw[t]));
                        const float kf = bf2f(xk[t]); const float kap = kf * kkc * xin[t]; const float av = bf2f(xa[t]); const float ec = cum;
                        bt[q] = kap * av * ec; dl[q] = kf * (1.f + (av - 1.f) * kac) * ec; }
                    dlp[t2] = pk2(dl[0], dl[1]); btp[t2] = pk2(bt[0], bt[1]);
                    BD[(2 * t2) * 72 + lane] = (bf16_t)(dlp[t2] & 0xffffu); BD[(2 * t2 + 1) * 72 + lane] = (bf16_t)(dlp[t2] >> 16);
                    BD[(16 + 2 * t2) * 72 + lane] = (bf16_t)(btp[t2] & 0xffffu); BD[(17 + 2 * t2) * 72 + lane] = (bf16_t)(btp[t2] >> 16); }
                *(LAS u32x4*)(BDT + lane * 40) = (u32x4){dlp[0], dlp[1], dlp[2], dlp[3]}; *(LAS u32x4*)(BDT + lane * 40 + 8) = (u32x4){dlp[4], dlp[5], dlp[6], dlp[7]};
                *(LAS u32x4*)(BDT + lane * 40 + 16) = (u32x4){btp[0], btp[1], btp[2], btp[3]}; *(LAS u32x4*)(BDT + lane * 40 + 24) = (u32x4){btp[4], btp[5], btp[6], btp[7]};
            }
            __syncthreads();
            f32x4 ya[4];
            const f32x4 z4 = (f32x4){0.f, 0.f, 0.f, 0.f};
            if (role == 0) {
                const bf16x8 a0 = ldfrag(AT, 72, fr, fq, 0), a1 = ldfrag(AT, 72, fr, fq, 1);
                const bf16x8 bd00 = ldfrag(BD, 72, fr, fq, 0), bd01 = ldfrag(BD, 72, fr, fq, 1), bd10 = ldfrag(BD + 16 * 72, 72, fr, fq, 0), bd11 = ldfrag(BD + 16 * 72, 72, fr, fq, 1);
                bf16x8 sb[4][2], pv[4];
#pragma unroll
                for (int vt = 0; vt < 4; ++vt) { sb[vt][0] = ldfrag(SB + 16 * vt * 72, 72, fr, fq, 0); sb[vt][1] = ldfrag(SB + 16 * vt * 72, 72, fr, fq, 1); pv[vt] = ldfrag(PVT + 16 * vt * 40, 40, fr, fq, 0); }
                const f32x4 d0 = MFMA16(a1, bd01, MFMA16(a0, bd00, z4));
                const f32x4 d1 = MFMA16(a1, bd11, MFMA16(a0, bd10, z4));
#pragma unroll
                for (int vt = 0; vt < 4; ++vt) ya[vt] = MFMA16(a1, sb[vt][1], MFMA16(a0, sb[vt][0], z4));
#pragma unroll
                for (int r = 0; r < 4; ++r) { const int t = 4 * fq + r; const bool lo = fr < t;
                    LADM[t * 40 + fr] = (bf16_t)(pk2(lo ? d0[r] : 0.f, 0.f) & 0xffffu); LADM[t * 40 + 16 + fr] = (bf16_t)0; }
                {   f32x4 lv; lv.x = (fr < 4 * fq + 0) ? d1.x : 0.f; lv.y = (fr < 4 * fq + 1) ? d1.y : 0.f; lv.z = (fr < 4 * fq + 2) ? d1.z : 0.f; lv.w = (fr < 4 * fq + 3) ? d1.w : 0.f;
                    *(LAS f32x4*)(LABT + fr * 16 + 4 * fq) = lv; }
                asm volatile("s_waitcnt lgkmcnt(0)" ::: "memory");
                const bf16x8 lad = ldfrag(LADM, 40, fr, fq, 0);
#pragma unroll
                for (int vt = 0; vt < 4; ++vt) ya[vt] = MFMA16(lad, pv[vt], ya[vt]);
#pragma unroll
                for (int vt = 0; vt < 4; ++vt)
#pragma unroll
                    for (int r = 0; r < 4; ++r) RHS[(4 * fq + r) * 64 + 16 * vt + fr] = -ya[vt][r];
            } else {
                const bf16x8 r0 = ldfrag(RT, 72, fr, fq, 0), r1 = ldfrag(RT, 72, fr, fq, 1);
                const bf16x8 bd00 = ldfrag(BD, 72, fr, fq, 0), bd01 = ldfrag(BD, 72, fr, fq, 1), bd10 = ldfrag(BD + 16 * 72, 72, fr, fq, 0), bd11 = ldfrag(BD + 16 * 72, 72, fr, fq, 1);
                bf16x8 sb[4][2];
#pragma unroll
                for (int vt = 0; vt < 4; ++vt) { sb[vt][0] = ldfrag(SB + 16 * vt * 72, 72, fr, fq, 0); sb[vt][1] = ldfrag(SB + 16 * vt * 72, 72, fr, fq, 1); }
                const f32x4 m0 = MFMA16(r1, bd01, MFMA16(r0, bd00, z4));
                const f32x4 m1 = MFMA16(r1, bd11, MFMA16(r0, bd10, z4));
#pragma unroll
                for (int vt = 0; vt < 4; ++vt) ya[vt] = MFMA16(sb[vt][1], r1, MFMA16(sb[vt][0], r0, z4));
#pragma unroll
                for (int r = 0; r < 4; ++r) { const int t = 4 * fq + r; const bool lo = fr <= t;
                    const unsigned pkd = pk2(lo ? m0[r] : 0.f, lo ? m1[r] : 0.f);
                    LM[t * 40 + fr] = (bf16_t)(pkd & 0xffffu); LM[t * 40 + 16 + fr] = (bf16_t)(pkd >> 16); }
            }
            asm volatile("s_waitcnt lgkmcnt(0)" ::: "memory");
            if (role == 0) {
                float acc[16];
#pragma unroll
                for (int t = 0; t < 16; ++t) acc[t] = RHS[t * 64 + lane];
#pragma unroll
                for (int i = 0; i < 15; ++i) { float col[16];
#pragma unroll
                    for (int q = 0; q < 4; ++q) if (4 * q + 3 > i) { const f32x4 lv = *(const LAS f32x4*)(LABT + i * 16 + 4 * q); col[4 * q] = lv.x; col[4 * q + 1] = lv.y; col[4 * q + 2] = lv.z; col[4 * q + 3] = lv.w; }
#pragma unroll
                    for (int t = 0; t < 16; ++t) if (t > i) acc[t] = fmaf(-col[t], acc[i], acc[t]); }
                *(LAS u32x4*)(PVT + lane * 40 + 16) = (u32x4){pk2(acc[0], acc[1]), pk2(acc[2], acc[3]), pk2(acc[4], acc[5]), pk2(acc[6], acc[7])};
                *(LAS u32x4*)(PVT + lane * 40 + 24) = (u32x4){pk2(acc[8], acc[9]), pk2(acc[10], acc[11]), pk2(acc[12], acc[13]), pk2(acc[14], acc[15])};
            }
            __syncthreads();
            if (ci + 1 < 144) WKV_STAGE();
            bf16x8 pvf[4];
#pragma unroll
            for (int vt = 0; vt < 4; ++vt) pvf[vt] = ldfrag(PVT + 16 * vt * 40, 40, fr, fq, 0);
            const bf16x8 bdf0 = ldfrag(BDT + 16 * (2 * role) * 40, 40, fr, fq, 0), bdf1 = ldfrag(BDT + 16 * (2 * role + 1) * 40, 40, fr, fq, 0);
            const f32x4 wcv0 = *(const LAS f32x4*)(WCa + 16 * (2 * role) + 4 * fq), wcv1 = *(const LAS f32x4*)(WCa + 16 * (2 * role + 1) + 4 * fq);
            if (role == 1) {
                const bf16x8 lmf = ldfrag(LM, 40, fr, fq, 0);
#pragma unroll
                for (int vt = 0; vt < 4; ++vt) ya[vt] = MFMA16(pvf[vt], lmf, ya[vt]);
            }
#pragma unroll
            for (int vt = 0; vt < 4; ++vt) { sacc[0][vt] = MFMA16(bdf0, pvf[vt], sacc[0][vt]); sacc[1][vt] = MFMA16(bdf1, pvf[vt], sacc[1][vt]); }
            if (role == 1) {
                if (ci >= 16) { const int s0 = (ci - 16) * 16;
                    const int sidx = s0 + fr; const size_t row = (size_t)(b * SEQ + (e ? (SEQ - 1 - sidx) : sidx));
#pragma unroll
                    for (int vt = 0; vt < 4; ++vt) { u32x2 o; o.x = pk2(ya[vt].x, ya[vt].y); o.y = pk2(ya[vt].z, ya[vt].w);
                        *(u32x2*)(Ae + row * D + cb + 16 * vt + 4 * fq) = o; } }
            }
#pragma unroll
            for (int i = 0; i < 2; ++i) { const int kt = 2 * role + i; const f32x4 wcv = i ? wcv1 : wcv0;
#pragma unroll
                for (int vt = 0; vt < 4; ++vt) { sacc[i][vt].x *= wcv.x; sacc[i][vt].y *= wcv.y; sacc[i][vt].z *= wcv.z; sacc[i][vt].w *= wcv.w;
                    u32x2 o; o.x = pk2(sacc[i][vt].x, sacc[i][vt].y); o.y = pk2(sacc[i][vt].z, sacc[i][vt].w);
                    *(LAS u32x2*)(SB + (16 * vt + fr) * 72 + 16 * kt + 4 * fq) = o; } }
            __syncthreads();
        }
#undef WKV_LOAD
#undef WKV_STAGE
#undef WKV_ROW
    }
}

__device__ __forceinline__ void phase_readout(Frame& F, const Args& a, const bf16_t* Y0, const bf16_t* Y1, const bf16_t* Rb, const bf16_t* Kb, const bf16_t* Vb, const bf16_t* Gb, bf16_t* O) {
    const int gw = F.bid * NWAVES + F.wave, NGW = F.G * NWAVES, RS = NGW >> 2;
    const int c = 8 * F.lane + 512 * (gw & 3);
    float rkv[8], lwv[8], lbv[8];
#pragma unroll
    for (int x = 0; x < 8; ++x) { rkv[x] = a.in[29][c + x]; lwv[x] = a.in[30][c + x]; lbv[x] = a.in[31][c + x]; }
    for (int r = gw >> 2; r < TL; r += 2 * RS) {
        u32x4 q[2][6];
#pragma unroll
        for (int u = 0; u < 2; ++u) { const int rr = r + u * RS; if (rr < TL) { const size_t off = (size_t)rr * D + c;
            q[u][0] = NTL((const u32x4*)(Y0 + off)); q[u][1] = NTL((const u32x4*)(Y1 + off)); q[u][2] = NTL((const u32x4*)(Rb + off));
            q[u][3] = NTL((const u32x4*)(Kb + off)); q[u][4] = NTL((const u32x4*)(Vb + off)); q[u][5] = NTL((const u32x4*)(Gb + off)); } }
#pragma unroll
        for (int u = 0; u < 2; ++u) { const int rr = r + u * RS; if (rr < TL) { const size_t off = (size_t)rr * D + c;
            float y0[8], y1[8], rr8[8], kk[8], vv[8], gg[8], y[8];
            unpack8(q[u][0], y0); unpack8(q[u][1], y1); unpack8(q[u][2], rr8); unpack8(q[u][3], kk); unpack8(q[u][4], vv); unpack8(q[u][5], gg);
            float s = 0.f, dt = 0.f;
#pragma unroll
            for (int x = 0; x < 8; ++x) { y[x] = y0[x] + y1[x]; s += y[x]; dt += rr8[x] * kk[x] * rkv[x]; }
            s = row8_sum(s); dt = row8_sum(dt);
            const float mean = s * (1.f / 64.f); float s2 = 0.f;
#pragma unroll
            for (int x = 0; x < 8; ++x) { y[x] -= mean; s2 += y[x] * y[x]; }
            s2 = row8_sum(s2);
            const float rstd = rsqrtf(s2 * (1.f / 64.f) + GN_EPS);
            float o[8];
#pragma unroll
            for (int x = 0; x < 8; ++x) o[x] = (y[x] * rstd * lwv[x] + lbv[x] + dt * vv[x]) * gg[x];
            u32x2 p; p.x = pk4_f8(o[0], o[1], o[2], o[3]); p.y = pk4_f8(o[4], o[5], o[6], o[7]); *(u32x2*)((unsigned char*)O + off) = p; } }
    }
}

__global__ void __launch_bounds__(NTHREADS, 2) fwd_kernel(Args args) {
    extern __shared__ __attribute__((aligned(16))) unsigned char lds_raw[];
    Frame F;
    F.lds = (LAS unsigned char*)lds_raw;
    F.tid = threadIdx.x; F.lane = F.tid & 63; F.wave = __builtin_amdgcn_readfirstlane(F.tid >> 6);
    F.G = gridDim.x; F.bid = blockIdx.x; F.ws = args.ws; F.out = args.out; F.ctl = (unsigned*)(args.ws + WS_CTL);
    volatile LAS unsigned* MISC = (volatile LAS unsigned*)(F.lds + LDS_MISC);
    if (F.tid < 64) MISC[F.tid] = 0u;
    __syncthreads();
    XcdBarrier bar = xcd_barrier_post(F.ctl + CW_BAR, MISC + 8);
    const int lo = args.ph_lo, hi = args.ph_hi;
#ifdef ONLY_PHASE
#define IN(k) ((k) == ONLY_PHASE)
#else
#define IN(k) (lo <= (k) && (k) < hi)
#endif
#define SEAM(k) do { if (IN(k) && IN((k) + 1)) xcd_barrier(bar); } while (0)
#ifndef DUPG
#define DUPG 0
#endif
#define REP(grp) if (((DUPG) >> (grp)) & 1)
    unsigned char* ws = args.ws;
    const float* MOD = (const float*)(ws + WS_MOD);
    LAS unsigned char* ring = F.lds;
    const LAS int* tstart = (const LAS int*)(F.lds + LDS_MISC + 256);

    if (IN(0)) { phase_prologue(F, args); REP(2) { __syncthreads(); phase_prologue(F, args); } }
    SEAM(0);
    if (IN(1)) { phase_modulate0(F, args); phase_router_build(F, args); }
    SEAM(1);
    if (IN(2)) {
        pg8::Gemm g{(const bf16_t*)(ws + WSLOT(0)), (const bf16_t*)(ws + WS_WIN), D / 2, D / 2, D / 2};
        PlainSched S{T / 256, NPROJ_PAD / 256, F.G, F.bid, (size_t)256 * D, (size_t)256 * D, 0, 0};
        EpiInProj E{(bf16_t*)(ws + WSLOT(1)), (bf16_t*)(ws + WSLOT(2)), (bf16_t*)(ws + WSLOT(1)) + (size_t)T * 1024, (float*)(ws + WS_DT), args.in[12]};
        pg8::gemm_phase<true>(ring, g, S, E);
        moe_convert_tail(F, args, (T / 256) * (NPROJ_PAD / 256), 0);
    }
    SEAM(2);
    if (IN(3)) {
        phase_conv(F, args); REP(3) { __syncthreads(); phase_conv(F, args); }
        __syncthreads();
        pg8::Gemm g{(const bf16_t*)(ws + WS_TW1), (const bf16_t*)(ws + WSLOT(1)) + (size_t)T * 1024, 128, 512, 128};
        Four1Sched S{F.G, F.bid};
        EpiFour1 E{(bf16_t*)(ws + WSLOT(6)), (bf16_t*)(ws + WSLOT(6) + (size_t)64 * 512 * SEQ)};
        pg8::gemm_phase<true>(ring, g, S, E);
    }
    SEAM(3);
    if (IN(4)) {
        phase_ssd_chunked(F, args); REP(1) { __syncthreads(); phase_ssd_chunked(F, args); }
        __syncthreads();
        {   pg8::Gemm g{(const bf16_t*)(ws + WS_TW2L), (const bf16_t*)(ws + WSLOT(6)), 2048, 2048, 2048};
            Four2Sched S{F.G, F.bid, 8, (size_t)256 * 4096, (size_t)512 * SEQ};
            EpiFour2 E{(bf16_t*)(ws + WSLOT(5)), 0, SEQ};
            pg8::gemm_phase<true>(ring, g, S, E); }
        {   pg8::Gemm g{(const bf16_t*)(ws + WS_TW2C), (const bf16_t*)(ws + WSLOT(6) + (size_t)64 * 512 * SEQ), 256, 256, 256};
            Four2Sched S{F.G, F.bid, 1, (size_t)256 * 512, (size_t)512 * CTXL};
            EpiFour2 E{(bf16_t*)(ws + WSLOT(5)), TL, CTXL};
            pg8::gemm_phase<true>(ring, g, S, E); }
    }
    SEAM(4);
    if (IN(5)) { phase_ssd_out(F, args); REP(3) { __syncthreads(); phase_ssd_out(F, args); } }
    SEAM(5);
    if (IN(6)) {
        pg8::Gemm g{(const bf16_t*)(ws + WSLOT(5)), (const bf16_t*)(ws + WS_WOUT), D / 2, D / 2, D / 2};
        PlainSched S{T / 256, D / 256, F.G, F.bid, (size_t)256 * D, (size_t)256 * D, 0, 0};
        EpiResid<false> E{(bf16_t*)(ws + WSLOT(0)), args.in[0], args.in[2], nullptr, MOD + 2 * 2048};
        pg8::gemm_phase<true>(ring, g, S, E);
        moe_convert_tail(F, args, (T / 256) * (D / 256), cvt_tail_items((T / 256) * (NPROJ_PAD / 256), F.G));
    }
    SEAM(6);
    if (IN(7)) { phase_ln_mid(F, args, 0, T, (const bf16_t*)(ws + WSLOT(0)), (bf16_t*)(ws + WSLOT(2)), (bf16_t*)(ws + WSLOT(3)), ws + WSLOT(4)); REP(3) { __syncthreads(); phase_ln_mid(F, args, 0, T, (const bf16_t*)(ws + WSLOT(0)), (bf16_t*)(ws + WSLOT(2)), (bf16_t*)(ws + WSLOT(3)), ws + WSLOT(4)); } }
    SEAM(7);
    if (IN(8)) {
        pg8::Gemm g{(const bf16_t*)(ws + WSLOT(2)), (const bf16_t*)(ws + WS_ROUTB), D, D, D};
        RouterSched S{F.G, F.bid, T / 256, 0};
        EpiRouter E{(float*)(ws + WS_LOGIT), (const float*)(F.ctl + CW_RB)};
        pg8::gemm_phase(ring, g, S, E);
        __threadfence_block(); __syncthreads();
        for (int u = F.bid; u < T / 256; u += F.G) phase_route_count(F, args, u * 256, 256, T, F.ctl + CW_CNT0);
        if (F.bid >= T / 256) phase_route_count(F, args, 0, 0, T, F.ctl + CW_CNT0);
        __syncthreads();
        moe_convert_tail(F, args, T / 256, cvt_tail_items((T / 256) * (NPROJ_PAD / 256), F.G) + cvt_tail_items((T / 256) * (D / 256), F.G));
    }
    SEAM(8);
    if (IN(10)) { phase_route_scatter(F, T, F.ctl + CW_CNT0); __syncthreads(); moe_convert_rest(F, args, cvt_tail_items((T / 256) * (NPROJ_PAD / 256), F.G) + cvt_tail_items((T / 256) * (D / 256), F.G) + cvt_tail_items(T / 256, F.G)); }
    SEAM(10);
    if (IN(11)) {
        moe_tables(F, F.ctl + CW_CNT0);
        pg8::Gemm g{(const bf16_t*)(ws + WSLOT(4)), (const bf16_t*)(ws + WS_MOE), D / 2, D / 2, D / 2};
        MoeSched S{F.G, F.bid, 4, tstart, (size_t)256 * D, MOE_E_ELEMS, (size_t)256 * D};
        EpiMoe1 E{ws + WSLOT(0)};
        pg8::gemm_phase_gather<true>(ring, g, (const int*)(ws + WS_TOK), S, E);
    }
    SEAM(11);
    if (IN(12)) {
        moe_tables(F, F.ctl + CW_CNT0);
        pg8::Gemm g{(const bf16_t*)(ws + WSLOT(0)), (const bf16_t*)(ws + WS_MOE + (size_t)1024 * 2048), 256, 256, 256};
        MoeSched S{F.G, F.bid, 8, tstart, (size_t)256 * 512, MOE_E_ELEMS, (size_t)256 * 512};
        EpiF8Plain E{ws + WSLOT(4), D, F8_WINV};
        pg8::gemm_phase<true>(ring, g, S, E);
    }
    SEAM(12);
    if (IN(13)) { phase_ln_final<false>(F, args, 0, T, (const bf16_t*)(ws + WSLOT(2)), (const bf16_t*)(ws + WSLOT(4)), (bf16_t*)(ws + WSLOT(1)), (bf16_t*)(ws + WSLOT(3))); REP(3) { __syncthreads(); phase_ln_final<false>(F, args, 0, T, (const bf16_t*)(ws + WSLOT(2)), (const bf16_t*)(ws + WSLOT(4)), (bf16_t*)(ws + WSLOT(1)), (bf16_t*)(ws + WSLOT(3))); } }
    SEAM(13);
    if (IN(14)) { phase_mixes6(F, args, (const bf16_t*)(ws + WSLOT(1)), ws + WSLOT(4)); }
    SEAM(14);
    if (IN(15)) {
        pg8::Gemm g{(const bf16_t*)(ws + WSLOT(4)), (const bf16_t*)(ws + WS_BT1), D / 2, D / 2, D / 2};
        RkvSched S{F.G, F.bid, (size_t)256 * D, (size_t)256 * D, SLOT};
        EpiRKV E{(bf16_t*)(ws + WSLOT(0)), (long)(2 * SLOT / 2), (long)((bf16_t*)F.out - (bf16_t*)(ws + WSLOT(0)))};
        pg8::gemm_phase<true>(ring, g, S, E);
    }
    if (IN(17)) {
        pg8::Gemm g{(const bf16_t*)(ws + WSLOT(4) + (size_t)T * D), (const bf16_t*)(ws + WS_BT1 + (size_t)6144 * D), D / 2, D / 2, D / 2};
        PlainSched S{T / 256, 3, F.G, F.bid, (size_t)256 * D, (size_t)256 * D, 1, SLOT};
        EpiLora1 E{(bf16_t*)(ws + WS_TW), (bf16_t*)(ws + WS_TA), (bf16_t*)(ws + WS_TG)};
        pg8::gemm_phase<true>(ring, g, S, E);
    }
    SEAM(17);
    if (IN(18)) {
        {   pg8::Gemm g{(const bf16_t*)(ws + WS_TW), (const bf16_t*)(ws + WS_BT2W), 128, 128, 128};
            PlainSched S{T / 256, 16, F.G, F.bid, (size_t)256 * 256, (size_t)256 * 256, 0, 0};
            EpiSigGrp E{(bf16_t*)(ws + WSLOT(3)), (bf16_t*)(ws + WSLOT(4)), args.in[19]};
            pg8::gemm_phase<true>(ring, g, S, E); }
        {   pg8::Gemm g{(const bf16_t*)(ws + WS_TA), (const bf16_t*)(ws + WS_BT2A), 128, 128, 128};
            PlainSched S{T / 256, 16, F.G, F.bid, (size_t)256 * 256, (size_t)256 * 256, 0, 0};
            EpiSigGrp E{(bf16_t*)(ws + WSLOT(5)), (bf16_t*)(ws + WSLOT(6)), args.in[22]};
            pg8::gemm_phase<true>(ring, g, S, E); }
        {   pg8::Gemm g{(const bf16_t*)(ws + WS_TG), (const bf16_t*)(ws + WS_G2T), 128, 128, 128};
            PlainSched S{TL / 256, 8, F.G, F.bid, (size_t)256 * 256, (size_t)256 * 256, 0, 0};
            EpiBf16Plain E{(bf16_t*)(ws + WS_MOE), D, F8_WINV};
            pg8::gemm_phase<true>(ring, g, S, E); }
    }
    SEAM(18);
    if (IN(19)) {
        phase_wkv_chunked(F, args, (const bf16_t*)(ws + WSLOT(0)), (const bf16_t*)(ws + WSLOT(2)), (const bf16_t*)F.out, (const bf16_t*)(ws + WSLOT(3)), (const bf16_t*)(ws + WSLOT(4)),
                       (bf16_t*)(ws + WSLOT(5)), (bf16_t*)(ws + WSLOT(6)));
    }
    SEAM(19);
    if (IN(20)) {
        phase_readout(F, args, (const bf16_t*)(ws + WSLOT(5)), (const bf16_t*)(ws + WSLOT(6)), (const bf16_t*)(ws + WSLOT(0)), (const bf16_t*)(ws + WSLOT(2)), (const bf16_t*)F.out,
                      (const bf16_t*)(ws + WS_MOE), (bf16_t*)(ws + WSLOT(3)));
        REP(3) phase_readout(F, args, (const bf16_t*)(ws + WSLOT(5)), (const bf16_t*)(ws + WSLOT(6)), (const bf16_t*)(ws + WSLOT(0)), (const bf16_t*)(ws + WSLOT(2)), (const bf16_t*)F.out,
                      (const bf16_t*)(ws + WS_MOE), (bf16_t*)(ws + WSLOT(3)));
    }
    SEAM(20);
    if (IN(21)) {
        pg8::Gemm g{(const bf16_t*)(ws + WSLOT(3)), (const bf16_t*)(ws + WS_WOT), D / 2, D / 2, D / 2};
        PlainSched S{TL / 256, D / 256, F.G, F.bid, (size_t)256 * D, (size_t)256 * D, 0, 0};
        EpiResid<true> E{(bf16_t*)(ws + WSLOT(4)), nullptr, nullptr, (const bf16_t*)(ws + WSLOT(1)), MOD + (size_t)17 * 12288 + 2 * 2048};
        pg8::gemm_phase<true>(ring, g, S, E);
    }
    SEAM(21);
    if (IN(22)) {
        phase_ln_mid(F, args, 1, TL, (const bf16_t*)(ws + WSLOT(4)), (bf16_t*)(ws + WSLOT(0)), (bf16_t*)(ws + WSLOT(2)), ws + WSLOT(1)); REP(3) { __syncthreads(); phase_ln_mid(F, args, 1, TL, (const bf16_t*)(ws + WSLOT(4)), (bf16_t*)(ws + WSLOT(0)), (bf16_t*)(ws + WSLOT(2)), ws + WSLOT(1)); }
        LAS float* scr = (LAS float*)(F.lds + F.wave * 8704);
        const int gw = F.bid * NWAVES + F.wave, NGW = F.G * NWAVES;
        const size_t lo1 = (size_t)NE * 2048 * 512;
        for (int it = gw; it < 32 * 1536; it += NGW) moe_convert_item(args.in[34] + lo1, args.in[35] + lo1, args.in[36] + lo1, (bf16_t*)(ws + WS_MOE), it, scr, F.lane);
        REP(2) for (int it = gw; it < 32 * 1536; it += NGW) moe_convert_item(args.in[34] + lo1, args.in[35] + lo1, args.in[36] + lo1, (bf16_t*)(ws + WS_MOE), it, scr, F.lane);
    }
    SEAM(22);
    if (IN(23)) {
        pg8::Gemm g{(const bf16_t*)(ws + WSLOT(0)), (const bf16_t*)(ws + WS_ROUTB), D, D, D};
        RouterSched S{F.G, F.bid, TL / 256, 544};
        EpiRouter E{(float*)(ws + WS_LOGIT), (const float*)(F.ctl + CW_RB) + 17 * 32};
        pg8::gemm_phase(ring, g, S, E);
        __threadfence_block(); __syncthreads();
        for (int u = F.bid; u < TL / 256; u += F.G) phase_route_count(F, args, u * 256, 256, TL, F.ctl + CW_CNT1);
        if (F.bid >= TL / 256) phase_route_count(F, args, 0, 0, TL, F.ctl + CW_CNT1);
    }
    SEAM(23);
    if (IN(25)) { phase_route_scatter(F, TL, F.ctl + CW_CNT1); }
    SEAM(25);
    if (IN(26)) {
        moe_tables(F, F.ctl + CW_CNT1);
        pg8::Gemm g{(const bf16_t*)(ws + WSLOT(1)), (const bf16_t*)(ws + WS_MOE), D / 2, D / 2, D / 2};
        MoeSched S{F.G, F.bid, 4, tstart, (size_t)256 * D, MOE_E_ELEMS, (size_t)256 * D};
        EpiMoe1 E{ws + WSLOT(6)};
        pg8::gemm_phase_gather<true>(ring, g, (const int*)(ws + WS_TOK), S, E);
    }
    SEAM(26);
    if (IN(27)) {
        moe_tables(F, F.ctl + CW_CNT1);
        pg8::Gemm g{(const bf16_t*)(ws + WSLOT(6)), (const bf16_t*)(ws + WS_MOE + (size_t)1024 * 2048), 256, 256, 256};
        MoeSched S{F.G, F.bid, 8, tstart, (size_t)256 * 512, MOE_E_ELEMS, (size_t)256 * 512};
        EpiF8Plain E{ws + WSLOT(3), D, F8_WINV};
        pg8::gemm_phase<true>(ring, g, S, E);
    }
    SEAM(27);
    if (IN(28)) { phase_ln_final<true>(F, args, 1, TL, (const bf16_t*)(ws + WSLOT(0)), (const bf16_t*)(ws + WSLOT(3)), nullptr, nullptr); REP(3) { __syncthreads(); phase_ln_final<true>(F, args, 1, TL, (const bf16_t*)(ws + WSLOT(0)), (const bf16_t*)(ws + WSLOT(3)), nullptr, nullptr); } }
#undef IN
#undef SEAM
}

constexpr int N_PHASES = 29;

extern "C" void kernel_launch(void* const* d_in, const int* in_sizes, int n_in, void* d_out, int out_size, void* d_ws, size_t ws_size, hipStream_t stream) {
    static int grid = 0;
    if (grid == 0) {
        if (n_in != 37 || out_size != TL * D || ws_size < WS_END) {
            fprintf(stderr, "kernel_launch: built for 37 inputs, out of %d floats, >= %zu bytes of workspace; got n_in %d, out %d, ws %zu; nothing launched\n", TL * D, (size_t)WS_END, n_in, out_size, ws_size);
            grid = -1; return; }
        int dev = 0, cus = 0, per_cu = 0;
        if (hipGetDevice(&dev) != hipSuccess || hipDeviceGetAttribute(&cus, hipDeviceAttributeMultiprocessorCount, dev) != hipSuccess) { fprintf(stderr, "kernel_launch: device query failed\n"); grid = -1; return; }
        if (hipFuncSetAttribute((const void*)fwd_kernel, hipFuncAttributeMaxDynamicSharedMemorySize, LDS_BYTES) != hipSuccess) { fprintf(stderr, "kernel_launch: hipFuncSetAttribute failed\n"); grid = -1; return; }
        if (hipOccupancyMaxActiveBlocksPerMultiprocessor(&per_cu, (const void*)fwd_kernel, NTHREADS, LDS_BYTES) != hipSuccess || per_cu < 1) {
            fprintf(stderr, "kernel_launch: occupancy query reports %d workgroups per CU; nothing launched\n", per_cu); (void)hipGetLastError(); grid = -1; return; }
        (void)hipGetLastError();
        grid = cus;
    }
    if (grid < 0) return;
    if (hipMemsetAsync((char*)d_ws + WS_CTL, 0, CTL_BYTES, stream) != hipSuccess) { fprintf(stderr, "kernel_launch: memset failed\n"); return; }
    Args a{};
    for (int i = 0; i < 37; ++i) a.in[i] = (const float*)d_in[i];
    a.out = (float*)d_out; a.ws = (unsigned char*)d_ws;
#ifndef MK_PER_PHASE
    a.ph_lo = 0; a.ph_hi = N_PHASES;
    hipLaunchKernelGGL(fwd_kernel, dim3(grid), dim3(NTHREADS), LDS_BYTES, stream, a);
#else
    for (int p = 0; p < N_PHASES; ++p) { a.ph_lo = p; a.ph_hi = p + 1; hipLaunchKernelGGL(fwd_kernel, dim3(grid), dim3(NTHREADS), LDS_BYTES, stream, a); }
#endif
    const hipError_t le = hipPeekAtLastError();
    if (le != hipSuccess) fprintf(stderr, "kernel_launch: launch failed: %s\n", hipGetErrorName(le));
}
```

```cpp
#include <hip/hip_runtime.h>
#include <cstdio>
#include <cstdint>
#include <cstddef>

#define LAS __attribute__((address_space(3)))
typedef unsigned short bf16_t;
typedef short bf16x8 __attribute__((ext_vector_type(8)));
typedef float f32x4 __attribute__((ext_vector_type(4)));
typedef unsigned u32x4 __attribute__((ext_vector_type(4)));
typedef unsigned u32x2 __attribute__((ext_vector_type(2)));

constexpr int D = 2048, NB = 16, SEQ = 2048, CTXL = 256;
constexpr int TL = NB * SEQ;
constexpr int TCX = NB * CTXL;
constexpr int T = TL + TCX;
constexpr int NPROJ = 3616, NPROJ_PAD = 3840;
constexpr int NE = 32;
constexpr float ALPHA = 1.41421356237f;
constexpr float LN_EPS = 1e-5f, GN_EPS = 64e-5f;
constexpr int NWAVES = 8, NTHREADS = 512;

constexpr size_t MiB = (size_t)1 << 20;
constexpr size_t WS_CTL = 0;
constexpr size_t CTL_BYTES = 65536;
constexpr size_t WS_MOD = 1 * MiB;
constexpr size_t WS_DT = 3 * MiB;
constexpr size_t WS_LOGIT = 8 * MiB;
constexpr size_t WS_ROUTE = 13 * MiB;
constexpr size_t WS_TOK = 13 * MiB + 640 * 1024;
constexpr size_t WS_INVN = 14 * MiB;
constexpr size_t WS_TW = 19 * MiB;
constexpr size_t WS_TA = 37 * MiB;
constexpr size_t WS_TG = 55 * MiB;
constexpr size_t WS_WIN = 73 * MiB;
constexpr size_t WS_WOUT = 88 * MiB;
constexpr size_t WS_BT1 = 96 * MiB;
constexpr size_t WS_BT2W = 123 * MiB;
constexpr size_t WS_BT2A = 125 * MiB;
constexpr size_t WS_G2T = 127 * MiB;
constexpr size_t WS_WOT = 128 * MiB;
constexpr size_t WS_ROUT = 136 * MiB;
constexpr size_t WS_TW1 = 137 * MiB;
constexpr size_t WS_TW2L = 138 * MiB;
constexpr size_t WS_TW2C = 154 * MiB;
constexpr size_t WS_MOE = 155 * MiB;
constexpr size_t WS_SLOT0 = 347 * MiB;
constexpr size_t SLOT = 144 * MiB;
constexpr size_t WS_END = WS_SLOT0 + 7 * SLOT;
#define WSLOT(i) (WS_SLOT0 + (size_t)(i) * SLOT)
constexpr int CW_BAR = 0;
constexpr int CW_CNT0 = 4096;
constexpr int CW_CNT1 = 4160;
constexpr int CW_RB = 8192;
constexpr size_t WS_ROUTB = 14 * MiB;
constexpr int CW_CVQ0 = 4224;
constexpr float F8_WSCALE = 64.f, F8_WINV = 1.f / 64.f;
constexpr size_t MOE_E_ELEMS = (size_t)1024 * 2048 + (size_t)2048 * 512;
constexpr int MOE_P0 = 81920;
constexpr int MOE_P1 = 73728;

constexpr int LDS_RING = 131072;
constexpr int LDS_MISC = 162816;
constexpr int LDS_BYTES = LDS_MISC + 1024;

__device__ __forceinline__ float bf2f(unsigned v16) { return __uint_as_float(v16 << 16); }
__device__ __forceinline__ float bflo(unsigned u) { return __uint_as_float(u << 16); }
__device__ __forceinline__ float bfhi(unsigned u) { return __uint_as_float(u & 0xffff0000u); }
typedef __bf16 bf16x2n_t __attribute__((ext_vector_type(2)));
typedef float f32x2n_t __attribute__((ext_vector_type(2)));
__device__ __forceinline__ unsigned pk2(float lo, float hi) { const f32x2n_t v = {lo, hi}; return __builtin_bit_cast(unsigned, __builtin_convertvector(v, bf16x2n_t)); }
__device__ __forceinline__ void unpack8(const u32x4 u, float (&f)[8]) {
    f[0] = bflo(u.x); f[1] = bfhi(u.x); f[2] = bflo(u.y); f[3] = bfhi(u.y); f[4] = bflo(u.z); f[5] = bfhi(u.z); f[6] = bflo(u.w); f[7] = bfhi(u.w);
}
__device__ __forceinline__ u32x4 pack8(const float (&f)[8]) { u32x4 o; o.x = pk2(f[0], f[1]); o.y = pk2(f[2], f[3]); o.z = pk2(f[4], f[5]); o.w = pk2(f[6], f[7]); return o; }
#define NTL(p) __builtin_nontemporal_load(p)
#define NTS(v, p) __builtin_nontemporal_store((v), (p))
__device__ __forceinline__ unsigned pk4_f8(float a, float b, float c, float d) { int p = 0; p = __builtin_amdgcn_cvt_pk_fp8_f32(a, b, p, false); p = __builtin_amdgcn_cvt_pk_fp8_f32(c, d, p, true); return (unsigned)p; }
typedef float f32x2_t __attribute__((ext_vector_type(2)));
__device__ __forceinline__ void unpack8_f8(const u32x2 u, float* f) {
    const f32x2_t a = __builtin_amdgcn_cvt_pk_f32_fp8((int)u.x, false), b = __builtin_amdgcn_cvt_pk_f32_fp8((int)u.x, true), c = __builtin_amdgcn_cvt_pk_f32_fp8((int)u.y, false), d = __builtin_amdgcn_cvt_pk_f32_fp8((int)u.y, true);
    f[0] = a.x; f[1] = a.y; f[2] = b.x; f[3] = b.y; f[4] = c.x; f[5] = c.y; f[6] = d.x; f[7] = d.y;
}
__device__ __forceinline__ float sigpre_(float u) { return __builtin_amdgcn_rcpf(1.f + __builtin_amdgcn_exp2f(u)); }
__device__ __forceinline__ float sigmoidf_(float x) { return __builtin_amdgcn_rcpf(1.f + __expf(-x)); }
__device__ __forceinline__ float siluf_(float x) { return x * __builtin_amdgcn_rcpf(1.f + __expf(-x)); }
__device__ __forceinline__ float softplusf_(float x) { return fmaxf(x, 0.f) + log1pf(__expf(-fabsf(x))); }
__device__ __forceinline__ float wave_sum(float v) {
#pragma unroll
    for (int o = 1; o < 64; o <<= 1) v += __shfl_xor(v, o);
    return v;
}
__device__ __forceinline__ float grp8_sum(float v) { v += __shfl_xor(v, 1); v += __shfl_xor(v, 2); v += __shfl_xor(v, 4); return v; }
__device__ __forceinline__ float dpp_add(float v, float moved) { return v + moved; }
__device__ __forceinline__ float row16_sum(float v) {
    v += __int_as_float(__builtin_amdgcn_update_dpp(0, __float_as_int(v), 0x128, 0xf, 0xf, false));
    v += __int_as_float(__builtin_amdgcn_update_dpp(0, __float_as_int(v), 0x124, 0xf, 0xf, false));
    v += __int_as_float(__builtin_amdgcn_update_dpp(0, __float_as_int(v), 0x122, 0xf, 0xf, false));
    v += __int_as_float(__builtin_amdgcn_update_dpp(0, __float_as_int(v), 0x121, 0xf, 0xf, false));
    return v;
}
__device__ __forceinline__ float row8_sum(float v) {
    v += __int_as_float(__builtin_amdgcn_update_dpp(0, __float_as_int(v), 0xB1, 0xf, 0xf, false));
    v += __int_as_float(__builtin_amdgcn_update_dpp(0, __float_as_int(v), 0x4E, 0xf, 0xf, false));
    v += __int_as_float(__builtin_amdgcn_update_dpp(0, __float_as_int(v), 0x141, 0xf, 0xf, false));
    return v;
}

#define XB_TMO      128
#define XB_XCNT(j)  (256  + 64 * (j))
#define XB_XSUB(j)  (1280 + 64 * (j))
#define XB_XGEN(j)  (2304 + 64 * (j))
#define XB_TOP      3328
#define XB_TOPGEN   3392
#define XCD_BAR_WORDS 3456
#define XB_SPIN_CAP (1u << 20)

__device__ __forceinline__ unsigned xb_ld(unsigned* p)              { return __hip_atomic_load(p, __ATOMIC_RELAXED, __HIP_MEMORY_SCOPE_AGENT); }
__device__ __forceinline__ unsigned xb_add(unsigned* p, unsigned v) { return __hip_atomic_fetch_add(p, v, __ATOMIC_RELAXED, __HIP_MEMORY_SCOPE_AGENT); }
__device__ __forceinline__ unsigned xb_xcc_id() { return (unsigned)__builtin_amdgcn_s_getreg((3 << 11) | 20) & 0xFu; }
#define XB_SPIN(cond, bar) do { unsigned _sp = 0; while (cond) { __builtin_amdgcn_s_sleep(1); \
    if ((++_sp & 255u) == 0u) { if (xb_ld(&(bar)[XB_TMO])) break; if (_sp > XB_SPIN_CAP) { atomicAdd(&(bar)[XB_TMO], 1u); break; } } } } while (0)

struct XcdBarrier { unsigned* bar; unsigned x; volatile LAS unsigned* st; };

__device__ __forceinline__ XcdBarrier xcd_barrier_post(unsigned* bar, volatile LAS unsigned* st) {
    XcdBarrier b; b.bar = bar; b.x = xb_xcc_id(); b.st = st;
    if (threadIdx.x == 0) (void)xb_add(&bar[XB_XCNT(b.x)], 1u);
    return b;
}
__device__ __forceinline__ void xcd_barrier_complete(unsigned* bar, unsigned x, unsigned& nloc, unsigned& nx) {
    const unsigned G = gridDim.x * gridDim.y * gridDim.z;
    unsigned sum, cnt, mine, sp = 0u;
    for (;;) {
        sum = 0u; cnt = 0u; mine = 0u;
#pragma unroll
        for (unsigned j = 0; j < 16; ++j) { const unsigned c = xb_ld(&bar[XB_XCNT(j)]); sum += c; cnt += (c > 0u) ? 1u : 0u; mine = (j == x) ? c : mine; }
        if (sum == G) break;
        __builtin_amdgcn_s_sleep(1);
        if ((++sp & 255u) == 0u) { if (xb_ld(&bar[XB_TMO])) break; if (sp > XB_SPIN_CAP) { atomicAdd(&bar[XB_TMO], 1u); break; } }
    }
    nloc = mine > 0u ? mine : 1u; nx = cnt > 0u ? cnt : 1u;
}
__device__ __forceinline__ void xcd_barrier(const XcdBarrier& b) {
    asm volatile("s_waitcnt vmcnt(0)" ::: "memory");
    __syncthreads();
    if (threadIdx.x == 0) {
        unsigned* bar = b.bar;
        __builtin_amdgcn_s_waitcnt(0);
        unsigned nloc = b.st[0], nx = b.st[1];
        if (nloc == 0u) { xcd_barrier_complete(bar, b.x, nloc, nx); b.st[0] = nloc; b.st[1] = nx; }
        const unsigned old = xb_add(&bar[XB_XSUB(b.x)], 1u);
        const unsigned gen = old / nloc;
        if (old + 1u == (gen + 1u) * nloc) {
            __builtin_amdgcn_fence(__ATOMIC_RELEASE, "agent");
            asm volatile("s_waitcnt vmcnt(0)" ::: "memory");
            const unsigned og = xb_add(&bar[XB_TOP], 1u);
            const unsigned tg = og / nx;
            if (og + 1u == (tg + 1u) * nx) xb_add(&bar[XB_TOPGEN], 1u);
            else XB_SPIN(xb_ld(&bar[XB_TOPGEN]) == tg, bar);
            __builtin_amdgcn_fence(__ATOMIC_ACQUIRE, "agent");
            xb_add(&bar[XB_XGEN(b.x)], 1u);
            asm volatile("s_waitcnt vmcnt(0)" ::: "memory");
        } else {
            XB_SPIN(xb_ld(&bar[XB_XGEN(b.x)]) == gen, bar);
            __builtin_amdgcn_fence(__ATOMIC_ACQUIRE, "agent");
            asm volatile("s_waitcnt vmcnt(0)" ::: "memory");
        }
    }
    __syncthreads();
}

namespace pg8 {
constexpr int BM = 256, BK = 64, HALF = 128, HTB = HALF * BK * 2, STAGE_BYTES = 8 * HTB, NXCD = 8, WGM = 8;
__device__ __forceinline__ int lds_byte(int r, int c) { const int st = (r >> 4) * 2 + (c >> 5), rr = r & 15, cc = c & 31, ob = rr * 64 + cc * 2; return st * 1024 + (ob ^ (((ob >> 9) & 1) << 5)); }
__device__ __forceinline__ int perm32(int rho) { const int n = rho >> 4, i = rho & 15; return 8 * (i >> 2) + 4 * n + (i & 3); }
__device__ __forceinline__ void stage_rc(int b, int& R, int& C) { const int st = b / 1024, sb = b % 1024, swz = sb ^ (((sb >> 9) & 1) << 5); R = (st >> 1) * 16 + swz / 64; C = (st & 1) * 32 + (swz % 64) / 2; }

struct Unit { int pm, pn, tag; size_t aoff, boff; };
struct Gemm { const bf16_t* A; const bf16_t* Bt; int lda, ldb, K; };

typedef int i32x8 __attribute__((ext_vector_type(8)));
typedef int i32x4 __attribute__((ext_vector_type(4)));
__device__ __forceinline__ f32x4 mfma_f8(const bf16x8 w0, const bf16x8 w1, const bf16x8 a0, const bf16x8 a1, const f32x4 c) {
    const i32x4 wl = __builtin_bit_cast(i32x4, w0), wh = __builtin_bit_cast(i32x4, w1), al = __builtin_bit_cast(i32x4, a0), ah = __builtin_bit_cast(i32x4, a1);
    const i32x8 wv = __builtin_shufflevector(wl, wh, 0, 1, 2, 3, 4, 5, 6, 7), av = __builtin_shufflevector(al, ah, 0, 1, 2, 3, 4, 5, 6, 7);
    f32x4 d = c; asm volatile("v_mfma_f32_16x16x128_f8f6f4 %0, %1, %2, %0" : "+v"(d) : "v"(wv), "v"(av)); return d;
}
__device__ __forceinline__ void f8_settle(f32x4 (&acc)[2][2][4][2]) {
    asm volatile("s_nop 7\n\ts_nop 7\n\ts_nop 7");
#pragma unroll
    for (int a = 0; a < 2; ++a)
#pragma unroll
        for (int b = 0; b < 2; ++b)
#pragma unroll
            for (int m = 0; m < 4; ++m) asm volatile("" : "+v"(acc[a][b][m][0]), "+v"(acc[a][b][m][1]));
    __builtin_amdgcn_sched_barrier(0);
}
__device__ __forceinline__ bool static_tile(int i, int G, int c, int nM, int nN, int& pm, int& pn) {
    const int nwg = nM * nN; const long L = (long)i * G + c; if (L >= nwg) return false;
    int wgid = (int)L; { const int q = nwg / NXCD, r = nwg % NXCD, xcd = wgid % NXCD, off = wgid / NXCD; wgid = (xcd < r ? xcd * (q + 1) : r * (q + 1) + (xcd - r) * q) + off; }
    const int nig = WGM * nN, gid = wgid / nig, fm = gid * WGM, gsz = (nM - fm) < WGM ? (nM - fm) : WGM;
    pm = fm + ((wgid % nig) % gsz); pn = (wgid % nig) / gsz; return true;
}

template <bool FP8 = false, class Epi, class Sched>
__device__ __forceinline__ void gemm_phase(LAS unsigned char* lds, const Gemm g, const Sched& S, const Epi& E) {
    const int tid = threadIdx.x, wid = __builtin_amdgcn_readfirstlane(tid >> 6), lane = tid & 63, wr = wid >> 2, wc = wid & 3, fr = lane & 15, fq = lane >> 4;
    const int K = g.K, nt = K / BK;
    unsigned voffA[2], voffB[2];
#pragma unroll
    for (int i = 0; i < 2; ++i) { int R, C; stage_rc(tid * 16 + i * 8192, R, C);
        voffA[i] = (unsigned)(R * g.lda + C) * 2u; voffB[i] = (unsigned)(((R & ~31) + perm32(R & 31)) * g.ldb + C) * 2u; }
    const size_t kstep = (size_t)(BK * 2);
    const size_t hstepA = (size_t)HALF * g.lda * 2, hstepB = (size_t)HALF * g.ldb * 2;
    const unsigned ldsw = (unsigned)wid * 1024u;
    const int aoff = lds_byte(wr * 64 + fr, fq * 8), boff = lds_byte(wc * 32 + fr, fq * 8);
#define PG8_SA(b, h) (((b) * 2 + (h)) * HTB)
#define PG8_SB(b, h) ((4 + (b) * 2 + (h)) * HTB)
#define PG8_STAGE(bufoff, gbase, voff) do { _Pragma("unroll") for (int _i = 0; _i < 2; ++_i) \
        __builtin_amdgcn_global_load_lds((const unsigned*)((const char*)(gbase) + (voff)[_i]), (LAS unsigned*)(lds + (bufoff) + ldsw + _i * 8192), 16, 0, 0); } while (0)
#define PG8_LDA(dst, b, h) do { _Pragma("unroll") for (int m = 0; m < 4; ++m) _Pragma("unroll") for (int k = 0; k < 2; ++k) dst[m][k] = *(const LAS bf16x8*)(lds + PG8_SA(b, h) + aoff + m * 2048 + k * 1024); } while (0)
#define PG8_LDB(dst, b, h) do { _Pragma("unroll") for (int n = 0; n < 2; ++n) _Pragma("unroll") for (int k = 0; k < 2; ++k) dst[n][k] = *(const LAS bf16x8*)(lds + PG8_SB(b, h) + boff + n * 2048 + k * 1024); } while (0)
#define PG8_MMA(ai, bj, At, Bt) do { __builtin_amdgcn_s_setprio(1); _Pragma("unroll") for (int m = 0; m < 4; ++m) _Pragma("unroll") for (int n = 0; n < 2; ++n) { \
        if constexpr (FP8) acc[ai][bj][m][n] = mfma_f8(Bt[n][0], Bt[n][1], At[m][0], At[m][1], acc[ai][bj][m][n]); \
        else { _Pragma("unroll") for (int k = 0; k < 2; ++k) acc[ai][bj][m][n] = __builtin_amdgcn_mfma_f32_16x16x32_bf16(Bt[n][k], At[m][k], acc[ai][bj][m][n], 0, 0, 0); } } \
        __builtin_amdgcn_s_setprio(0); } while (0)
#define PG8_WAIT_V(n) asm volatile("s_waitcnt vmcnt(" #n ")" ::: "memory")
#define PG8_WAIT_L(n) asm volatile("s_waitcnt lgkmcnt(" #n ")" ::: "memory")
#define PG8_BAR __builtin_amdgcn_s_barrier()
#define PG8_SCHED __builtin_amdgcn_sched_barrier(0)
    Unit cur, nxt; int ui = 0;
    if (!S.next(0, cur)) return;
    f32x4 acc[2][2][4][2];
#pragma unroll
    for (int a = 0; a < 2; ++a)
#pragma unroll
        for (int b = 0; b < 2; ++b)
#pragma unroll
            for (int m = 0; m < 4; ++m)
#pragma unroll
                for (int n = 0; n < 2; ++n) acc[a][b][m][n] = (f32x4){0.f, 0.f, 0.f, 0.f};
    bf16x8 At[4][2], B0[2][2], B1[2][2];
    const char* cA = (const char*)g.A + cur.aoff; const char* cB = (const char*)g.Bt + cur.boff;
    PG8_STAGE(PG8_SB(0, 0), cB, voffB); PG8_STAGE(PG8_SA(0, 0), cA, voffA); PG8_STAGE(PG8_SB(0, 1), cB + hstepB, voffB); PG8_STAGE(PG8_SA(0, 1), cA + hstepA, voffA);
    if (wr == 1) PG8_BAR;
    PG8_WAIT_V(4); PG8_BAR;
    PG8_STAGE(PG8_SB(1, 0), cB + kstep, voffB); PG8_STAGE(PG8_SA(1, 0), cA + kstep, voffA); PG8_STAGE(PG8_SB(1, 1), cB + hstepB + kstep, voffB);
    PG8_WAIT_V(6); PG8_BAR;
    for (;;) {
        const bool has_next = S.next(ui + 1, nxt);
        const char* nA = has_next ? (const char*)g.A + nxt.aoff : cA; const char* nB = has_next ? (const char*)g.Bt + nxt.boff : cB;
        for (int t = 0; t < nt; t += 2) {
            const bool last = (t == nt - 2);
            const char* a1 = cA + (size_t)(t + 1) * kstep;
            const char* a2 = last ? nA : cA + (size_t)(t + 2) * kstep; const char* b2 = last ? nB : cB + (size_t)(t + 2) * kstep;
            const char* a3 = a2 + kstep; const char* b3 = b2 + kstep;
            PG8_LDB(B0, 0, 0); PG8_SCHED; PG8_LDA(At, 0, 0); PG8_STAGE(PG8_SA(1, 1), a1 + hstepA, voffA);
            PG8_WAIT_L(8); PG8_BAR; PG8_WAIT_L(0); PG8_MMA(0, 0, At, B0); PG8_BAR; PG8_SCHED;
            PG8_LDB(B1, 0, 1); PG8_STAGE(PG8_SB(0, 0), b2, voffB);
            PG8_BAR; PG8_WAIT_L(0); PG8_MMA(0, 1, At, B1); PG8_BAR;
            PG8_LDA(At, 0, 1); PG8_STAGE(PG8_SA(0, 0), a2, voffA);
            PG8_BAR; PG8_WAIT_L(0); PG8_MMA(1, 0, At, B0); PG8_BAR; PG8_SCHED;
            PG8_STAGE(PG8_SB(0, 1), b2 + hstepB, voffB);
            PG8_WAIT_V(6); PG8_BAR; PG8_MMA(1, 1, At, B1); PG8_BAR;
            PG8_LDB(B0, 1, 0); PG8_SCHED; PG8_LDA(At, 1, 0); PG8_STAGE(PG8_SA(0, 1), a2 + hstepA, voffA);
            PG8_WAIT_L(8); PG8_BAR; PG8_WAIT_L(0); PG8_MMA(0, 0, At, B0); PG8_BAR; PG8_SCHED;
            PG8_LDB(B1, 1, 1); PG8_STAGE(PG8_SB(1, 0), b3, voffB);
            PG8_BAR; PG8_WAIT_L(0); PG8_MMA(0, 1, At, B1); PG8_BAR;
            PG8_LDA(At, 1, 1); PG8_STAGE(PG8_SA(1, 0), a3, voffA);
            PG8_BAR; PG8_WAIT_L(0); PG8_MMA(1, 0, At, B0); PG8_BAR; PG8_SCHED;
            PG8_STAGE(PG8_SB(1, 1), b3 + hstepB, voffB);
            PG8_WAIT_V(6); PG8_BAR; PG8_MMA(1, 1, At, B1); PG8_BAR;
        }
        {
            if constexpr (FP8) f8_settle(acc);
            int tz = threadIdx.x; asm volatile("" : "+v"(tz));
            const int ewid = tz >> 6, elane = tz & 63;
            E(acc, cur, ewid >> 2, ewid & 3, elane & 15, elane >> 4); }
        if (!has_next) break;
#pragma unroll
        for (int a = 0; a < 2; ++a)
#pragma unroll
            for (int b = 0; b < 2; ++b)
#pragma unroll
                for (int m = 0; m < 4; ++m)
#pragma unroll
                    for (int n = 0; n < 2; ++n) acc[a][b][m][n] = (f32x4){0.f, 0.f, 0.f, 0.f};
        cur = nxt; cA = nA; cB = nB; ++ui;
    }
    PG8_WAIT_V(0);
    if (wr == 0) PG8_BAR;
    PG8_BAR;
#undef PG8_SA
#undef PG8_SB
#undef PG8_STAGE
#undef PG8_LDA
#undef PG8_LDB
#undef PG8_MMA
#undef PG8_WAIT_V
#undef PG8_WAIT_L
#undef PG8_BAR
#undef PG8_SCHED
}

template <bool FP8 = false, class Epi, class Sched>
__device__ __forceinline__ void gemm_phase_gather(LAS unsigned char* lds, const Gemm g, const int* tok, const Sched& S, const Epi& E) {
    const int tid = threadIdx.x, wid = __builtin_amdgcn_readfirstlane(tid >> 6), lane = tid & 63, wr = wid >> 2, wc = wid & 3, fr = lane & 15, fq = lane >> 4;
    const int K = g.K, nt = K / BK;
    unsigned vg0[2], vg1[2], ng0[2], ng1[2], voffB[2];
#pragma unroll
    for (int i = 0; i < 2; ++i) { int R, C; stage_rc(tid * 16 + i * 8192, R, C); voffB[i] = (unsigned)(((R & ~31) + perm32(R & 31)) * g.ldb + C) * 2u; }
#define PG8_GOFFS(d0_, d1_, tile_) do { _Pragma("unroll") for (int i_ = 0; i_ < 2; ++i_) { int R_, C_; stage_rc(tid * 16 + i_ * 8192, R_, C_); \
        const int t0_ = tok[(size_t)(tile_) * 256 + R_], t1_ = tok[(size_t)(tile_) * 256 + 128 + R_]; \
        d0_[i_] = (unsigned)(t0_ * g.lda + C_) * 2u; d1_[i_] = (unsigned)(t1_ * g.lda + C_) * 2u; } } while (0)
    const size_t kstep = (size_t)(BK * 2);
    const size_t hstepB = (size_t)HALF * g.ldb * 2;
    const unsigned ldsw = (unsigned)wid * 1024u;
    const int aoff = lds_byte(wr * 64 + fr, fq * 8), boff = lds_byte(wc * 32 + fr, fq * 8);
#define PG8_SA(b, h) (((b) * 2 + (h)) * HTB)
#define PG8_SB(b, h) ((4 + (b) * 2 + (h)) * HTB)
#define PG8_STAGE(bufoff, gbase, voff) do { _Pragma("unroll") for (int _i = 0; _i < 2; ++_i) \
        __builtin_amdgcn_global_load_lds((const unsigned*)((const char*)(gbase) + (voff)[_i]), (LAS unsigned*)(lds + (bufoff) + ldsw + _i * 8192), 16, 0, 0); } while (0)
#define PG8_STAGE_G(bufoff, koff, voff) do { _Pragma("unroll") for (int _i = 0; _i < 2; ++_i) \
        __builtin_amdgcn_global_load_lds((const unsigned*)((const char*)g.A + (unsigned)((voff)[_i] + (unsigned)(koff))), (LAS unsigned*)(lds + (bufoff) + ldsw + _i * 8192), 16, 0, 0); } while (0)
#define PG8_LDA(dst, b, h) do { _Pragma("unroll") for (int m = 0; m < 4; ++m) _Pragma("unroll") for (int k = 0; k < 2; ++k) dst[m][k] = *(const LAS bf16x8*)(lds + PG8_SA(b, h) + aoff + m * 2048 + k * 1024); } while (0)
#define PG8_LDB(dst, b, h) do { _Pragma("unroll") for (int n = 0; n < 2; ++n) _Pragma("unroll") for (int k = 0; k < 2; ++k) dst[n][k] = *(const LAS bf16x8*)(lds + PG8_SB(b, h) + boff + n * 2048 + k * 1024); } while (0)
#define PG8_MMA(ai, bj, At, Bt) do { __builtin_amdgcn_s_setprio(1); _Pragma("unroll") for (int m = 0; m < 4; ++m) _Pragma("unroll") for (int n = 0; n < 2; ++n) { \
        if constexpr (FP8) acc[ai][bj][m][n] = mfma_f8(Bt[n][0], Bt[n][1], At[m][0], At[m][1], acc[ai][bj][m][n]); \
        else { _Pragma("unroll") for (int k = 0; k < 2; ++k) acc[ai][bj][m][n] = __builtin_amdgcn_mfma_f32_16x16x32_bf16(Bt[n][k], At[m][k], acc[ai][bj][m][n], 0, 0, 0); } } \
        __builtin_amdgcn_s_setprio(0); } while (0)
#define PG8_WAIT_V(n) asm volatile("s_waitcnt vmcnt(" #n ")" ::: "memory")
#define PG8_WAIT_L(n) asm volatile("s_waitcnt lgkmcnt(" #n ")" ::: "memory")
#define PG8_BAR __builtin_amdgcn_s_barrier()
#define PG8_SCHED __builtin_amdgcn_sched_barrier(0)
    Unit cur, nxt; int ui = 0;
    if (!S.next(0, cur)) return;
    f32x4 acc[2][2][4][2];
#pragma unroll
    for (int a = 0; a < 2; ++a)
#pragma unroll
        for (int b = 0; b < 2; ++b)
#pragma unroll
            for (int m = 0; m < 4; ++m)
#pragma unroll
                for (int n = 0; n < 2; ++n) acc[a][b][m][n] = (f32x4){0.f, 0.f, 0.f, 0.f};
    bf16x8 At[4][2], B0[2][2], B1[2][2];
    const char* cB = (const char*)g.Bt + cur.boff;
    PG8_GOFFS(vg0, vg1, cur.pm);
    PG8_STAGE(PG8_SB(0, 0), cB, voffB); PG8_STAGE_G(PG8_SA(0, 0), 0, vg0); PG8_STAGE(PG8_SB(0, 1), cB + hstepB, voffB); PG8_STAGE_G(PG8_SA(0, 1), 0, vg1);
    if (wr == 1) PG8_BAR;
    PG8_WAIT_V(4); PG8_BAR;
    PG8_STAGE(PG8_SB(1, 0), cB + kstep, voffB); PG8_STAGE_G(PG8_SA(1, 0), kstep, vg0); PG8_STAGE(PG8_SB(1, 1), cB + hstepB + kstep, voffB);
    PG8_WAIT_V(6); PG8_BAR;
    for (;;) {
        const bool has_next = S.next(ui + 1, nxt);
        const char* nB = has_next ? (const char*)g.Bt + nxt.boff : cB;
        if (has_next) PG8_GOFFS(ng0, ng1, nxt.pm); else { ng0[0] = vg0[0]; ng0[1] = vg0[1]; ng1[0] = vg1[0]; ng1[1] = vg1[1]; }
        for (int t = 0; t < nt; t += 2) {
            const bool last = (t == nt - 2);
            const unsigned a1 = (unsigned)(t + 1) * (unsigned)kstep, a2 = last ? 0u : (unsigned)(t + 2) * (unsigned)kstep, a3 = a2 + (unsigned)kstep;
            const char* b2 = last ? nB : cB + (size_t)(t + 2) * kstep; const char* b3 = b2 + kstep;
            unsigned w0[2], w1[2];
            w0[0] = last ? ng0[0] : vg0[0]; w0[1] = last ? ng0[1] : vg0[1]; w1[0] = last ? ng1[0] : vg1[0]; w1[1] = last ? ng1[1] : vg1[1];
            PG8_LDB(B0, 0, 0); PG8_SCHED; PG8_LDA(At, 0, 0); PG8_STAGE_G(PG8_SA(1, 1), a1, vg1);
            PG8_WAIT_L(8); PG8_BAR; PG8_WAIT_L(0); PG8_MMA(0, 0, At, B0); PG8_BAR; PG8_SCHED;
            PG8_LDB(B1, 0, 1); PG8_STAGE(PG8_SB(0, 0), b2, voffB);
            PG8_BAR; PG8_WAIT_L(0); PG8_MMA(0, 1, At, B1); PG8_BAR;
            PG8_LDA(At, 0, 1); PG8_STAGE_G(PG8_SA(0, 0), a2, w0);
            PG8_BAR; PG8_WAIT_L(0); PG8_MMA(1, 0, At, B0); PG8_BAR; PG8_SCHED;
            PG8_STAGE(PG8_SB(0, 1), b2 + hstepB, voffB);
            PG8_WAIT_V(6); PG8_BAR; PG8_MMA(1, 1, At, B1); PG8_BAR;
            PG8_LDB(B0, 1, 0); PG8_SCHED; PG8_LDA(At, 1, 0); PG8_STAGE_G(PG8_SA(0, 1), a2, w1);
            PG8_WAIT_L(8); PG8_BAR; PG8_WAIT_L(0); PG8_MMA(0, 0, At, B0); PG8_BAR; PG8_SCHED;
            PG8_LDB(B1, 1, 1); PG8_STAGE(PG8_SB(1, 0), b3, voffB);
            PG8_BAR; PG8_WAIT_L(0); PG8_MMA(0, 1, At, B1); PG8_BAR;
            PG8_LDA(At, 1, 1); PG8_STAGE_G(PG8_SA(1, 0), a3, w0);
            PG8_BAR; PG8_WAIT_L(0); PG8_MMA(1, 0, At, B0); PG8_BAR; PG8_SCHED;
            PG8_STAGE(PG8_SB(1, 1), b3 + hstepB, voffB);
            PG8_WAIT_V(6); PG8_BAR; PG8_MMA(1, 1, At, B1); PG8_BAR;
        }
        {
            if constexpr (FP8) f8_settle(acc);
            int tz = threadIdx.x; asm volatile("" : "+v"(tz));
            const int ewid = tz >> 6, elane = tz & 63;
            E(acc, cur, ewid >> 2, ewid & 3, elane & 15, elane >> 4); }
        if (!has_next) break;
#pragma unroll
        for (int a = 0; a < 2; ++a)
#pragma unroll
            for (int b = 0; b < 2; ++b)
#pragma unroll
                for (int m = 0; m < 4; ++m)
#pragma unroll
                    for (int n = 0; n < 2; ++n) acc[a][b][m][n] = (f32x4){0.f, 0.f, 0.f, 0.f};
        cur = nxt; cB = nB; ++ui; vg0[0] = ng0[0]; vg0[1] = ng0[1]; vg1[0] = ng1[0]; vg1[1] = ng1[1];
    }
    PG8_WAIT_V(0);
    if (wr == 0) PG8_BAR;
    PG8_BAR;
#undef PG8_SA
#undef PG8_SB
#undef PG8_STAGE
#undef PG8_LDA
#undef PG8_LDB
#undef PG8_MMA
#undef PG8_WAIT_V
#undef PG8_WAIT_L
#undef PG8_BAR
#undef PG8_SCHED
#undef PG8_GOFFS
#undef PG8_STAGE_G
}

template <class F>
__device__ __forceinline__ void for_each_acc(const f32x4 (&acc)[2][2][4][2], const Unit& u, int wr, int wc, int fr, int fq, const F& f) {
    const int row0 = u.pm * BM + wr * 64 + fr, col0 = u.pn * BM + wc * 32 + 8 * fq;
#pragma unroll
    for (int ai = 0; ai < 2; ++ai)
#pragma unroll
        for (int m = 0; m < 4; ++m)
#pragma unroll
            for (int bj = 0; bj < 2; ++bj) { f(row0 + ai * HALF + m * 16, col0 + bj * HALF, acc[ai][bj][m][0], acc[ai][bj][m][1]); }
}
}

struct Args { const float* in[37]; float* out; unsigned char* ws; int ph_lo, ph_hi; };

struct Frame {
    LAS unsigned char* lds;
    int tid, lane, wave, G, bid;
    unsigned char* ws;
    float* out;
    unsigned* ctl;
};

__device__ __forceinline__ void st_bf16x4(bf16_t* p, const f32x4 v) { u32x2 o; o.x = pk2(v.x, v.y); o.y = pk2(v.z, v.w); *(u32x2*)p = o; }
__device__ __forceinline__ void st_bf16x8(bf16_t* p, const f32x4 a, const f32x4 b) { u32x4 o; o.x = pk2(a.x, a.y); o.y = pk2(a.z, a.w); o.z = pk2(b.x, b.y); o.w = pk2(b.z, b.w); *(u32x4*)p = o; }

struct PlainSched {
    int nM, nN, G, c; size_t a_tile, b_tile; int agrp; size_t astride;
    __device__ __forceinline__ bool next(int i, pg8::Unit& u) const {
        int pm, pn; if (!pg8::static_tile(i, G, c, nM, nN, pm, pn)) return false;
        u.pm = pm; u.pn = pn; u.tag = 0; u.aoff = (size_t)pm * a_tile + (agrp ? (size_t)(pn / agrp) * astride : 0); u.boff = (size_t)pn * b_tile; return true;
    }
};
struct RkvSched {
    int G, c; size_t a_tile, b_tile, astride;
    __device__ __forceinline__ bool next(int i, pg8::Unit& u) const {
        int pm, pn; constexpr int NLAT = (TL / 256) * 24;
        const long L = (long)i * G + c;
        if (L < NLAT) { if (!pg8::static_tile(0, G, (int)L, TL / 256, 24, pm, pn)) return false; }
        else { if (!pg8::static_tile(0, G, (int)(L - NLAT), TCX / 256, 16, pm, pn)) return false; pm += TL / 256; pn += 8; }
        u.pm = pm; u.pn = pn; u.tag = 0; u.aoff = (size_t)pm * a_tile + (size_t)(pn >> 3) * astride; u.boff = (size_t)pn * b_tile; return true;
    }
};
struct Four1Sched {
    int G, c;
    __device__ __forceinline__ bool next(int i, pg8::Unit& u) const {
        const long L = (long)i * G + c; if (L >= 1152) return false;
        const int l = (int)L;
        if (l < 1024) { const int batch = l >> 4, pm = (l >> 3) & 1, pn = l & 7, b = batch >> 2, g = batch & 3;
            u.pm = pm; u.pn = pn; u.tag = batch; u.aoff = (size_t)pm * 256 * 256 * 2; u.boff = ((size_t)(b * SEQ + pn * 256) * 1024 + g * 256) * 2; }
        else { const int uu = l - 1024, batch = uu >> 1, pm = uu & 1, b = batch >> 2, g = batch & 3;
            u.pm = pm; u.pn = 0; u.tag = 64 + batch; u.aoff = (size_t)pm * 256 * 256 * 2; u.boff = ((size_t)(TL + b * CTXL) * 1024 + g * 256) * 2; }
        return true;
    }
};
struct Four2Sched {
    int G, c, npm; size_t a_tile, b_batch;
    __device__ __forceinline__ bool next(int i, pg8::Unit& u) const {
        const long L = (long)i * G + c; if (L >= 64 * npm) return false;
        const int l = (int)L, batch = l / npm, pm = l % npm;
        u.pm = pm; u.pn = 0; u.tag = batch; u.aoff = (size_t)pm * a_tile; u.boff = (size_t)batch * b_batch; return true;
    }
};
struct RouterSched {
    int G, c, nM, rowbase;
    __device__ __forceinline__ bool next(int i, pg8::Unit& u) const {
        const long L = (long)i * G + c; if (L >= nM) return false;
        const int pm = (int)L, b = (pm * 256 < TL) ? (pm >> 3) : 16;
        u.pm = pm; u.pn = 0; u.tag = b; u.aoff = (size_t)pm * 256 * D * 2; u.boff = (size_t)(rowbase + 32 * b) * D * 2; return true;
    }
};
struct MoeSched {
    int G, c, NT; const LAS int* tstart; size_t a_tile, b_exp, b_tile;
    __device__ __forceinline__ bool next(int i, pg8::Unit& u) const {
        const long L = (long)i * G + c; const int total = __builtin_amdgcn_readfirstlane(tstart[32]) * NT; if (L >= total) return false;
        int l = (int)L; { const int q = total / 8, r = total % 8, xcd = l % 8, off = l / 8; l = (xcd < r ? xcd * (q + 1) : r * (q + 1) + (xcd - r) * q) + off; }
        const int tile = l / NT, pn = l % NT;
        int e = 0;
#pragma unroll 1
        for (int k = 1; k < 32; ++k) e += (__builtin_amdgcn_readfirstlane(tstart[k]) <= tile) ? 1 : 0;
        u.pm = tile; u.pn = pn; u.tag = e; u.aoff = (size_t)tile * a_tile; u.boff = (size_t)e * b_exp + (size_t)pn * b_tile; return true;
    }
};

typedef f32x4 AccT[2][2][4][2];
struct EpiInProj {
    bf16_t *Z, *XBC, *F; float* DT; const float* dt_bias;
    __device__ __forceinline__ void operator()(const AccT& acc, const pg8::Unit& u, int wr, int wc, int fr, int fq) const {
        pg8::for_each_acc(acc, u, wr, wc, fr, fq, [&](int r, int c, const f32x4 w0, const f32x4 w1) { const f32x4 v0 = w0 * F8_WINV, v1 = w1 * F8_WINV;
            if (c < 1024) st_bf16x8(Z + (size_t)r * 1024 + c, v0, v1);
            else if (c < 2560) st_bf16x8(XBC + (size_t)r * 1536 + (c - 1024), v0, v1);
            else if (c < 2592) { const int j = c - 2560; const f32x4 b0 = *(const f32x4*)(dt_bias + j), b1 = *(const f32x4*)(dt_bias + j + 4); f32x4 o0, o1;
                o0.x = softplusf_(v0.x + b0.x); o0.y = softplusf_(v0.y + b0.y); o0.z = softplusf_(v0.z + b0.z); o0.w = softplusf_(v0.w + b0.w);
                o1.x = softplusf_(v1.x + b1.x); o1.y = softplusf_(v1.y + b1.y); o1.z = softplusf_(v1.z + b1.z); o1.w = softplusf_(v1.w + b1.w);
                *(f32x4*)(DT + (size_t)r * 32 + j) = o0; *(f32x4*)(DT + (size_t)r * 32 + j + 4) = o1; }
            else if (c < NPROJ) st_bf16x8(F + (size_t)r * 1024 + (c - 2592), v0, v1);
        });
    }
};
struct EpiFour1 {
    bf16_t *GL, *GC;
    __device__ __forceinline__ void operator()(const AccT& acc, const pg8::Unit& u, int wr, int wc, int fr, int fq) const {
        const bool lat = u.tag < 64; const int batch = lat ? u.tag : u.tag - 64; const int L = lat ? SEQ : CTXL;
        unsigned char* base = (unsigned char*)(lat ? +GL : +GC) + (size_t)batch * 512 * L;
        pg8::for_each_acc(acc, u, wr, wc, fr, fq, [&](int r, int c, const f32x4 v0, const f32x4 v1) {
            u32x2 p; p.x = pk4_f8(v0.x, v0.y, v0.z, v0.w); p.y = pk4_f8(v1.x, v1.y, v1.z, v1.w); *(u32x2*)(base + (size_t)r * L + c) = p; });
    }
};
struct EpiFour2 {
    bf16_t* MIX; int rowbase0, L;
    __device__ __forceinline__ void operator()(const AccT& acc, const pg8::Unit& u, int wr, int wc, int fr, int fq) const {
        const int b = u.tag >> 2, g = u.tag & 3;
        unsigned char* base = (unsigned char*)MIX + (size_t)(rowbase0 + b * L) * D + 1024 + g * 256;
        pg8::for_each_acc(acc, u, wr, wc, fr, fq, [&](int r, int c, const f32x4 v0, const f32x4 v1) {
            const f32x4 w0 = v0 * F8_WINV, w1 = v1 * F8_WINV;
            u32x2 p; p.x = pk4_f8(w0.x, w0.y, w0.z, w0.w); p.y = pk4_f8(w1.x, w1.y, w1.z, w1.w); *(u32x2*)(base + (size_t)r * D + c) = p; });
    }
};
template <bool RES_BF16>
struct EpiResid {
    bf16_t* V; const float* xl; const float* xc; const bf16_t* xb; const float* gate;
    __device__ __forceinline__ void operator()(const AccT& acc, const pg8::Unit& u, int wr, int wc, int fr, int fq) const {
        const int mr = (u.pm * 256 < TL) ? ((u.pm * 256) >> 11) : 16;
        const int col0 = u.pn * 256 + wc * 32 + 8 * fq;
        const float* gp = gate + (size_t)mr * 12288 + col0;
        const f32x4 g00 = *(const f32x4*)gp, g01 = *(const f32x4*)(gp + 4), g10 = *(const f32x4*)(gp + 128), g11 = *(const f32x4*)(gp + 132);
        pg8::for_each_acc(acc, u, wr, wc, fr, fq, [&](int r, int c, const f32x4 w0, const f32x4 w1) { const f32x4 v0 = w0 * F8_WINV, v1 = w1 * F8_WINV;
            const bool hi = (c - col0) != 0;
            const f32x4 g0 = hi ? g10 : g00, g1 = hi ? g11 : g01;
            f32x4 x0, x1;
            if (RES_BF16) { const u32x4 p = NTL((const u32x4*)(xb + (size_t)r * D + c)); x0.x = bflo(p.x); x0.y = bfhi(p.x); x0.z = bflo(p.y); x0.w = bfhi(p.y); x1.x = bflo(p.z); x1.y = bfhi(p.z); x1.z = bflo(p.w); x1.w = bfhi(p.w); }
            else { const float* xp = (r < TL) ? xl + (size_t)r * D + c : xc + (size_t)(r - TL) * D + c; x0 = NTL((const f32x4*)xp); x1 = NTL((const f32x4*)(xp + 4)); }
            f32x4 o0, o1;
            o0.x = ALPHA * x0.x + g0.x * v0.x; o0.y = ALPHA * x0.y + g0.y * v0.y; o0.z = ALPHA * x0.z + g0.z * v0.z; o0.w = ALPHA * x0.w + g0.w * v0.w;
            o1.x = ALPHA * x1.x + g1.x * v1.x; o1.y = ALPHA * x1.y + g1.y * v1.y; o1.z = ALPHA * x1.z + g1.z * v1.z; o1.w = ALPHA * x1.w + g1.w * v1.w;
            st_bf16x8(V + (size_t)r * D + c, o0, o1);
        });
    }
};
struct EpiRouter {
    float* LG; const float* bias;
    __device__ __forceinline__ void operator()(const AccT& acc, const pg8::Unit& u, int wr, int wc, int fr, int fq) const {
        pg8::for_each_acc(acc, u, wr, wc, fr, fq, [&](int r, int c, const f32x4 v0, const f32x4 v1) { if (c < 32) { const f32x4 b0 = *(const f32x4*)(bias + u.tag * 32 + c), b1 = *(const f32x4*)(bias + u.tag * 32 + c + 4);
            *(f32x4*)(LG + (size_t)r * 32 + c) = v0 + b0; *(f32x4*)(LG + (size_t)r * 32 + c + 4) = v1 + b1; } });
    }
};
struct EpiMoe1 {
    unsigned char* HID;
    __device__ __forceinline__ void operator()(const AccT& acc, const pg8::Unit& u, int wr, int wc, int fr, int fq) const {
        const int row0 = u.pm * 256 + wr * 64 + fr, col0 = u.pn * 128 + wc * 32 + 8 * fq;
#pragma unroll
        for (int ai = 0; ai < 2; ++ai)
#pragma unroll
            for (int m = 0; m < 4; ++m) { f32x4 o[2];
#pragma unroll
                for (int n = 0; n < 2; ++n) { const f32x4 g = acc[ai][0][m][n] * F8_WINV, up = acc[ai][1][m][n] * F8_WINV;
                    o[n].x = siluf_(g.x) * up.x; o[n].y = siluf_(g.y) * up.y; o[n].z = siluf_(g.z) * up.z; o[n].w = siluf_(g.w) * up.w; }
                u32x2 p; p.x = pk4_f8(o[0].x, o[0].y, o[0].z, o[0].w); p.y = pk4_f8(o[1].x, o[1].y, o[1].z, o[1].w);
                *(u32x2*)(HID + (size_t)(row0 + ai * 128 + m * 16) * 512 + col0) = p; }
    }
};
struct EpiBf16Plain {
    bf16_t* O; int ld; float scale;
    __device__ __forceinline__ void operator()(const AccT& acc, const pg8::Unit& u, int wr, int wc, int fr, int fq) const {
        pg8::for_each_acc(acc, u, wr, wc, fr, fq, [&](int r, int c, const f32x4 v0, const f32x4 v1) { st_bf16x8(O + (size_t)r * ld + c, v0 * scale, v1 * scale); });
    }
};
struct EpiF8Plain {
    unsigned char* O; int ld; float scale;
    __device__ __forceinline__ void operator()(const AccT& acc, const pg8::Unit& u, int wr, int wc, int fr, int fq) const {
        pg8::for_each_acc(acc, u, wr, wc, fr, fq, [&](int r, int c, const f32x4 v0, const f32x4 v1) { const f32x4 a = v0 * scale, b = v1 * scale;
            u32x2 p; p.x = pk4_f8(a.x, a.y, a.z, a.w); p.y = pk4_f8(b.x, b.y, b.z, b.w); *(u32x2*)(O + (size_t)r * ld + c) = p; });
    }
};
struct EpiRKV {
    bf16_t* R; long dK, dV;
    __device__ __forceinline__ void operator()(const AccT& acc, const pg8::Unit& u, int wr, int wc, int fr, int fq) const {
        const int grp = u.pn >> 3; bf16_t* base = R + (grp == 1 ? dK : 0l) + (grp == 2 ? dV : 0l);
        pg8::for_each_acc(acc, u, wr, wc, fr, fq, [&](int r, int c, const f32x4 v0, const f32x4 v1) { st_bf16x8(base + (size_t)r * D + (c & 2047), v0 * F8_WINV, v1 * F8_WINV); });
    }
};
struct EpiLora1 {
    bf16_t *TW, *TA, *TG;
    __device__ __forceinline__ void operator()(const AccT& acc, const pg8::Unit& u, int wr, int wc, int fr, int fq) const {
        const int grp = u.pn; unsigned char* base = (unsigned char*)(grp == 0 ? +TW : (grp == 1 ? +TA : +TG));
        pg8::for_each_acc(acc, u, wr, wc, fr, fq, [&](int r, int c, f32x4 v0, f32x4 v1) { v0 *= F8_WINV; v1 *= F8_WINV;
            if (grp == 0) { v0.x = tanhf(v0.x); v0.y = tanhf(v0.y); v0.z = tanhf(v0.z); v0.w = tanhf(v0.w); v1.x = tanhf(v1.x); v1.y = tanhf(v1.y); v1.z = tanhf(v1.z); v1.w = tanhf(v1.w); }
            else if (grp == 2) { v0.x = sigmoidf_(v0.x); v0.y = sigmoidf_(v0.y); v0.z = sigmoidf_(v0.z); v0.w = sigmoidf_(v0.w); v1.x = sigmoidf_(v1.x); v1.y = sigmoidf_(v1.y); v1.z = sigmoidf_(v1.z); v1.w = sigmoidf_(v1.w); }
            u32x2 p; p.x = pk4_f8(v0.x, v0.y, v0.z, v0.w); p.y = pk4_f8(v1.x, v1.y, v1.z, v1.w);
            *(u32x2*)(base + (size_t)r * 256 + (c & 255)) = p; });
    }
};
struct EpiSigGrp {
    bf16_t *O0, *O1; const float* bias;
    __device__ __forceinline__ void operator()(const AccT& acc, const pg8::Unit& u, int wr, int wc, int fr, int fq) const {
        const int e = u.pn >> 3; bf16_t* base = O0 + (e ? (O1 - O0) : 0l);
        const int col0 = u.pn * 256 + wc * 32 + 8 * fq;
        const float* bp = bias + e * 2048 + (col0 & 2047);
        constexpr float NL2E = -1.4426950409f;
        const f32x4 b00 = *(const f32x4*)bp * NL2E, b01 = *(const f32x4*)(bp + 4) * NL2E, b10 = *(const f32x4*)(bp + 128) * NL2E, b11 = *(const f32x4*)(bp + 132) * NL2E;
        pg8::for_each_acc(acc, u, wr, wc, fr, fq, [&](int r, int c, const f32x4 v0, const f32x4 v1) {
            const bool hi = (c - col0) != 0;
            st_bf16x8(base + (size_t)r * D + (c & 2047), v0 * (F8_WINV * NL2E) + (hi ? b10 : b00), v1 * (F8_WINV * NL2E) + (hi ? b11 : b01)); });
    }
};

__device__ __forceinline__ void transpose_item(const float* W, int N, int k0, int n0, bf16_t* dst, int ldd, LAS float* scr, int lane) {
#pragma unroll 8
    for (int i = 0; i < 32; ++i) { const int kk = 2 * i + (lane >> 5); scr[kk * 33 + (lane & 31)] = NTL(W + (size_t)(k0 + kk) * N + n0 + (lane & 31)); }
    asm volatile("s_waitcnt lgkmcnt(0)" ::: "memory");
    const int c = lane & 7;
#pragma unroll
    for (int j = 0; j < 4; ++j) { const int n = (lane >> 3) + 8 * j; const LAS float* s = scr + (8 * c) * 33 + n;
        u32x4 o; o.x = pk2(s[0 * 33], s[1 * 33]); o.y = pk2(s[2 * 33], s[3 * 33]); o.z = pk2(s[4 * 33], s[5 * 33]); o.w = pk2(s[6 * 33], s[7 * 33]);
        *(u32x4*)(dst + (size_t)n * ldd + 8 * c) = o; }
    asm volatile("s_waitcnt lgkmcnt(0)" ::: "memory");
}
__device__ __forceinline__ void transpose_plain(const float* W, int K, int N, bf16_t* dst, int ldd, int item, LAS float* scr, int lane) {
    const int nblk = N / 32, kb = item / nblk, nb = item % nblk;
    transpose_item(W, N, kb * 64, nb * 32, dst + (size_t)(nb * 32) * ldd + kb * 64, ldd, scr, lane);
}
__device__ __forceinline__ void transpose_item_f8(const float* W, int N, int k0, int n0, unsigned char* dst, int ldd, LAS float* scr, int lane) {
#pragma unroll 8
    for (int i = 0; i < 32; ++i) { const int kk = 2 * i + (lane >> 5); scr[kk * 33 + (lane & 31)] = NTL(W + (size_t)(k0 + kk) * N + n0 + (lane & 31)); }
    asm volatile("s_waitcnt lgkmcnt(0)" ::: "memory");
    const int c = lane & 7;
#pragma unroll
    for (int j = 0; j < 4; ++j) { const int n = (lane >> 3) + 8 * j; const LAS float* sp = scr + (8 * c) * 33 + n;
        u32x2 o; o.x = pk4_f8(sp[0 * 33] * F8_WSCALE, sp[1 * 33] * F8_WSCALE, sp[2 * 33] * F8_WSCALE, sp[3 * 33] * F8_WSCALE);
        o.y = pk4_f8(sp[4 * 33] * F8_WSCALE, sp[5 * 33] * F8_WSCALE, sp[6 * 33] * F8_WSCALE, sp[7 * 33] * F8_WSCALE);
        *(u32x2*)(dst + (size_t)n * ldd + 8 * c) = o; }
    asm volatile("s_waitcnt lgkmcnt(0)" ::: "memory");
}
__device__ __forceinline__ void transpose_plain_f8(const float* W, int K, int N, unsigned char* dst, int ldd, int item, LAS float* scr, int lane) {
    const int nblk = N / 32, kb = item / nblk, nb = item % nblk;
    transpose_item_f8(W, N, kb * 64, nb * 32, dst + (size_t)(nb * 32) * ldd + kb * 64, ldd, scr, lane);
}
__device__ __forceinline__ void moe_convert_item(const float* wg, const float* wu, const float* wd, bf16_t* moe, int item, LAS float* scr, int lane) {
    const int e = item / 1536, r = item % 1536;
    unsigned char* eb = (unsigned char*)moe + (size_t)e * MOE_E_ELEMS;
    if (r < 1024) { const int mat = r >> 9, it = r & 511;
        const float* W = (mat ? wu : wg) + (size_t)e * 2048 * 512;
        const int kb = it / 16, nb = it % 16, n0 = nb * 32, pn = n0 >> 7, j = n0 & 127;
        transpose_item_f8(W, 512, kb * 64, n0, eb + (size_t)(pn * 256 + mat * 128 + j) * 2048 + kb * 64, 2048, scr, lane);
    } else { const int it = r - 1024;
        const float* W = wd + (size_t)e * 512 * 2048;
        const int kb = it / 64, nb = it % 64;
        transpose_item_f8(W, 2048, kb * 64, nb * 32, eb + (size_t)1024 * 2048 + (size_t)(nb * 32) * 512 + kb * 64, 512, scr, lane);
    }
}

constexpr int CVT_PER_IDLE_UNIT = 13;
__device__ __forceinline__ void moe_convert_tail(Frame& F, const Args& a, int U, int base) {
    const int first_idle = U % F.G;
    if (first_idle == 0 || F.bid < first_idle) return;
    LAS float* scr = (LAS float*)(F.lds + F.wave * 8704);
    const int nwk = (F.G - first_idle) * NWAVES, wk = (F.bid - first_idle) * NWAVES + F.wave;
    for (int k = 0; k < CVT_PER_IDLE_UNIT; ++k) { const int it = base + k * nwk + wk; if (it < 32 * 1536) moe_convert_item(a.in[34], a.in[35], a.in[36], (bf16_t*)(F.ws + WS_MOE), it, scr, F.lane); }
}
__device__ __forceinline__ int cvt_tail_items(int U, int G) { const int fi = U % G; return fi ? (G - fi) * NWAVES * CVT_PER_IDLE_UNIT : 0; }
__device__ __forceinline__ void moe_convert_rest(Frame& F, const Args& a, int first) {
    LAS float* scr = (LAS float*)(F.lds + F.wave * 8704);
    for (int it = first + F.bid * NWAVES + F.wave; it < 32 * 1536; it += F.G * NWAVES) moe_convert_item(a.in[34], a.in[35], a.in[36], (bf16_t*)(F.ws + WS_MOE), it, scr, F.lane);
}

__device__ __forceinline__ void phase_prologue(Frame& F, const Args& a) {
    LAS float* scr = (LAS float*)(F.lds + F.wave * 8704);
    const int gw = F.bid * NWAVES + F.wave, NGW = F.G * NWAVES;
    unsigned char* ws = F.ws;
    bf16_t* WIN = (bf16_t*)(ws + WS_WIN); bf16_t* WOUT = (bf16_t*)(ws + WS_WOUT); bf16_t* BT1 = (bf16_t*)(ws + WS_BT1);
    bf16_t* G2T = (bf16_t*)(ws + WS_G2T); bf16_t* WOT = (bf16_t*)(ws + WS_WOT); bf16_t* ROUT = (bf16_t*)(ws + WS_ROUT);
    constexpr int I_IN = 32 * 113, I_SQ = 32 * 64, I_L96 = 32 * 3, I_G1 = 32 * 8, I_G2 = 4 * 64, I_RT = 32;
    constexpr int NITEMS = I_IN + I_SQ + 3 * I_SQ + 4 * I_L96 + I_G1 + I_G2 + I_SQ + I_RT;
    for (int it = gw; it < NITEMS; it += NGW) {
        int r = it;
        if (r < I_IN) { transpose_plain_f8(a.in[8], 2048, NPROJ, (unsigned char*)WIN, 2048, r, scr, F.lane); continue; } r -= I_IN;
        if (r < I_SQ) { transpose_plain_f8(a.in[15], 2048, 2048, (unsigned char*)WOUT, 2048, r, scr, F.lane); continue; } r -= I_SQ;
        if (r < 3 * I_SQ) { const int j = r / I_SQ; transpose_plain_f8(a.in[17] + (size_t)j * 2048 * 2048, 2048, 2048, (unsigned char*)BT1 + (size_t)j * 2048 * 2048, 2048, r % I_SQ, scr, F.lane); continue; } r -= 3 * I_SQ;
        if (r < 2 * I_L96) { const int e = r / I_L96; transpose_plain_f8(a.in[20] + (size_t)e * 2048 * 96, 2048, 96, (unsigned char*)BT1 + (size_t)(6144 + e * 96) * 2048, 2048, r % I_L96, scr, F.lane); continue; } r -= 2 * I_L96;
        if (r < 2 * I_L96) { const int e = r / I_L96; transpose_plain_f8(a.in[23] + (size_t)e * 2048 * 96, 2048, 96, (unsigned char*)BT1 + (size_t)(6400 + e * 96) * 2048, 2048, r % I_L96, scr, F.lane); continue; } r -= 2 * I_L96;
        if (r < I_G1) { transpose_plain_f8(a.in[25], 2048, 256, (unsigned char*)BT1 + (size_t)6656 * 2048, 2048, r, scr, F.lane); continue; } r -= I_G1;
        if (r < I_G2) { transpose_plain_f8(a.in[26], 256, 2048, (unsigned char*)G2T, 256, r, scr, F.lane); continue; } r -= I_G2;
        if (r < I_SQ) { transpose_plain_f8(a.in[18], 2048, 2048, (unsigned char*)WOT, 2048, r, scr, F.lane); continue; } r -= I_SQ;
        transpose_plain(a.in[32], 2048, 32, ROUT, 2048, r, scr, F.lane);
    }
    const size_t gt = (size_t)F.bid * NTHREADS + F.tid, NGT = (size_t)F.G * NTHREADS;
    {   unsigned char* B2W = ws + WS_BT2W; unsigned char* B2A = ws + WS_BT2A;
        for (size_t i4 = gt; i4 < (size_t)2 * 4096 * 64; i4 += NGT) {
            const int which = (int)(i4 / (4096 * 64)); const int rem = (int)(i4 % (4096 * 64));
            const int nrow = rem % 4096, k4 = rem / 4096, e = nrow >> 11, n = nrow & 2047;
            const float* src = which ? a.in[24] : a.in[21]; float v[4];
#pragma unroll
            for (int x = 0; x < 4; ++x) { const int k = 4 * k4 + x - e * 96; v[x] = (k >= 0 && k < 96) ? src[((size_t)e * 96 + k) * 2048 + n] * F8_WSCALE : 0.f; }
            *(unsigned*)((which ? B2A : B2W) + (size_t)nrow * 256 + 4 * k4) = pk4_f8(v[0], v[1], v[2], v[3]);
        }
    }
    {   const u32x4 z = (u32x4){0u, 0u, 0u, 0u};
        u32x4* p0 = (u32x4*)((unsigned char*)WIN + (size_t)NPROJ * 2048); const size_t n0 = (size_t)(NPROJ_PAD - NPROJ) * 2048 / 16;
        for (size_t i = gt; i < n0; i += NGT) p0[i] = z;
        u32x4* p1 = (u32x4*)((unsigned char*)BT1 + (size_t)6336 * 2048); u32x4* p2 = (u32x4*)((unsigned char*)BT1 + (size_t)6592 * 2048); const size_t n1 = (size_t)64 * 2048 / 16;
        for (size_t i = gt; i < n1; i += NGT) { p1[i] = z; p2[i] = z; }
        u32x4* p3 = (u32x4*)(ROUT + (size_t)32 * 2048); const size_t n3 = (size_t)224 * 2048 / 8;
        for (size_t i = gt; i < n3; i += NGT) p3[i] = z;
    }
    {   bf16_t* T1 = (bf16_t*)(ws + WS_TW1); bf16_t* T2L = (bf16_t*)(ws + WS_TW2L); bf16_t* T2C = (bf16_t*)(ws + WS_TW2C);
        const float TWO_PI = 6.283185307179586f;
        for (size_t idx = gt; idx < (size_t)512 * 256; idx += NGT) { const int m = (int)(idx >> 8), cc = (int)(idx & 255), n = m >> 1, part = m & 1;
            const float ang = TWO_PI * (float)((n * cc) & 255) * (1.f / 256.f); const float v = (part ? -sinf(ang) : cosf(ang)) * (1.f / 16.f);
            T1[idx] = (bf16_t)(pk2(v, 0.f) & 0xffffu); }
        for (size_t i4 = gt; i4 < (size_t)2048 * 4096 / 4; i4 += NGT) { const size_t idx = i4 * 4; const int lp = (int)(idx >> 12), kk = (int)(idx & 4095), part = kk >> 11, l = kk & 2047; float v[4];
#pragma unroll
            for (int x = 0; x < 4; ++x) { const float ang = TWO_PI * (float)((lp * (l + x)) & 2047) * (1.f / 2048.f); v[x] = (part ? sinf(ang) : cosf(ang)) * (0.022097086912079608f * F8_WSCALE); }
            *(unsigned*)((unsigned char*)T2L + idx) = pk4_f8(v[0], v[1], v[2], v[3]); }
        for (size_t i4 = gt; i4 < (size_t)256 * 512 / 4; i4 += NGT) { const size_t idx = i4 * 4; const int lp = (int)(idx >> 9), kk = (int)(idx & 511), part = kk >> 8, l = kk & 255; float v[4];
#pragma unroll
            for (int x = 0; x < 4; ++x) { const float ang = TWO_PI * (float)((lp * (l + x)) & 255) * (1.f / 256.f); v[x] = (part ? sinf(ang) : cosf(ang)) * ((1.f / 16.f) * F8_WSCALE); }
            *(unsigned*)((unsigned char*)T2C + idx) = pk4_f8(v[0], v[1], v[2], v[3]); }
    }
    {   float* MOD = (float*)(ws + WS_MOD);
        LAS float* sl = (LAS float*)F.lds;
        LAS float* red = (LAS float*)(F.lds + 139264);
        const int kq = F.tid >> 5, nl = F.tid & 31;
        __syncthreads();
        for (int idx = F.tid; idx < 17 * 2048; idx += NTHREADS) { const int r = idx >> 11, kk = idx & 2047;
            const float cvv = (r < 16) ? a.in[1][r * 2048 + kk] : a.in[3][kk]; sl[idx] = siluf_(cvv); }
        __syncthreads();
        for (int unit = F.bid; unit < 768; unit += F.G) {
            const int i = unit / 384, n0 = (unit % 384) * 32;
            const float* Wp = a.in[4] + (size_t)i * 2048 * 12288 + (size_t)(kq * 128) * 12288 + n0 + nl;
            float accv[17];
#pragma unroll
            for (int r = 0; r < 17; ++r) accv[r] = 0.f;
#pragma unroll 1
            for (int kb = 0; kb < 16; ++kb) { float wv[8];
#pragma unroll
                for (int x = 0; x < 8; ++x) wv[x] = NTL(Wp + (size_t)(kb * 8 + x) * 12288);
#pragma unroll
                for (int x4 = 0; x4 < 2; ++x4) {
#pragma unroll
                    for (int r = 0; r < 17; ++r) { const f32x4 sv = *(const LAS f32x4*)(sl + r * 2048 + kq * 128 + kb * 8 + x4 * 4);
                        accv[r] += wv[4 * x4] * sv.x + wv[4 * x4 + 1] * sv.y + wv[4 * x4 + 2] * sv.z + wv[4 * x4 + 3] * sv.w; }
                    __builtin_amdgcn_sched_barrier(0); } }
#pragma unroll
            for (int r = 0; r < 17; ++r) { accv[r] += __shfl_xor(accv[r], 32); if ((F.tid & 32) == 0) red[((kq >> 1) * 17 + r) * 32 + nl] = accv[r]; }
            __syncthreads();
            for (int idx = F.tid; idx < 17 * 32; idx += NTHREADS) { const int r = idx >> 5, n = idx & 31; float sacc = a.in[5][i * 12288 + n0 + n];
#pragma unroll
                for (int q = 0; q < 8; ++q) sacc += red[(q * 17 + r) * 32 + n];
                MOD[((size_t)i * 17 + r) * 12288 + n0 + n] = sacc; }
            __syncthreads();
        }
    }
}

#define LNC(j) (8 * F.lane + 512 * (j))
__device__ __forceinline__ void phase_modulate0(Frame& F, const Args& a) {
    const int gw = F.bid * NWAVES + F.wave, NGW = F.G * NWAVES;
    const float* MOD = (const float*)(F.ws + WS_MOD);
    bf16_t* H = (bf16_t*)(F.ws + WSLOT(0));
    const int rpw = (T + NGW - 1) / NGW, r0 = gw * rpw, r1 = (r0 + rpw < T) ? r0 + rpw : T;
    f32x4 scv[4][2], shv[4][2]; int cur = -1;
    for (int rb = r0; rb < r1; rb += 2) {
        f32x4 x[2][4][2];
#pragma unroll
        for (int u = 0; u < 2; ++u) { const int r = rb + u; if (r < r1) { const float* src = r < TL ? a.in[0] + (size_t)r * D : a.in[2] + (size_t)(r - TL) * D;
#pragma unroll
            for (int j = 0; j < 4; ++j)
#pragma unroll
                for (int h = 0; h < 2; ++h) x[u][j][h] = NTL((const f32x4*)(src + LNC(j) + 4 * h)); } }
#pragma unroll
        for (int u = 0; u < 2; ++u) { const int r = rb + u; if (r < r1) {
            const int mr = r < TL ? (r >> 11) : 16;
            if (mr != cur) { cur = mr; const float* sh = MOD + (size_t)mr * 12288; const float* sc = sh + 2048;
#pragma unroll
                for (int j = 0; j < 4; ++j)
#pragma unroll
                    for (int h = 0; h < 2; ++h) { const int c = LNC(j) + 4 * h; const f32x4 s1 = *(const f32x4*)(sc + c); shv[j][h] = *(const f32x4*)(sh + c);
                        scv[j][h].x = 1.f + s1.x; scv[j][h].y = 1.f + s1.y; scv[j][h].z = 1.f + s1.z; scv[j][h].w = 1.f + s1.w; } }
#pragma unroll
            for (int j = 0; j < 4; ++j) { f32x4 o[2];
#pragma unroll
                for (int h = 0; h < 2; ++h) { const f32x4 xv = x[u][j][h];
                    o[h].x = xv.x * scv[j][h].x + shv[j][h].x; o[h].y = xv.y * scv[j][h].y + shv[j][h].y; o[h].z = xv.z * scv[j][h].z + shv[j][h].z; o[h].w = xv.w * scv[j][h].w + shv[j][h].w; }
                u32x2 p; p.x = pk4_f8(o[0].x, o[0].y, o[0].z, o[0].w); p.y = pk4_f8(o[1].x, o[1].y, o[1].z, o[1].w);
                *(u32x2*)((unsigned char*)H + (size_t)r * D + LNC(j)) = p; } } }
    }
}
__device__ __forceinline__ void phase_router_build(Frame& F, const Args& a) {
    const size_t gt = (size_t)F.bid * NTHREADS + F.tid, NGT = (size_t)F.G * NTHREADS;
    const float* Wr = a.in[32]; bf16_t* RB = (bf16_t*)(F.ws + WS_ROUTB);
    const float* MOD = (const float*)(F.ws + WS_MOD);
    for (size_t i8 = gt; i8 < (size_t)1056 * 256; i8 += NGT) {
        const int row = (int)(i8 >> 8), k0 = (int)(i8 & 255) * 8, layer = row >= 544 ? 1 : 0, rr = row - 544 * layer, b = rr >> 5, e = rr & 31;
        const float* sc = MOD + (size_t)layer * 17 * 12288 + (size_t)b * 12288 + 4 * 2048 + k0;
        float o[8];
#pragma unroll
        for (int x = 0; x < 8; ++x) o[x] = (1.f + sc[x]) * Wr[(size_t)(k0 + x) * 32 + e];
        *(u32x4*)(RB + (size_t)row * D + k0) = pack8(o);
    }
    const int gw = F.bid * NWAVES + F.wave, NGW = F.G * NWAVES;
    for (int row = gw; row < 1056; row += NGW) {
        const int layer = row >= 544 ? 1 : 0, rr = row - 544 * layer, b = rr >> 5, e = rr & 31;
        const float* sh = MOD + (size_t)layer * 17 * 12288 + (size_t)b * 12288 + 3 * 2048;
        float acc = 0.f;
        for (int k = F.lane; k < D; k += 64) acc += sh[k] * Wr[(size_t)k * 32 + e];
        acc = wave_sum(acc);
        if (F.lane == 0) ((float*)(F.ctl + CW_RB))[row] = acc;
    }
}
__device__ __forceinline__ void phase_conv(Frame& F, const Args& a) {
    const int gw = F.bid * NWAVES + F.wave, NGW = F.G * NWAVES;
    const bf16_t* XBC = (const bf16_t*)(F.ws + WSLOT(2)); bf16_t* XC = (bf16_t*)(F.ws + WSLOT(3));
    const float* cw = a.in[9]; const float* cb = a.in[10];
    float w0[3][8], w1[3][8], w2[3][8], bb[3][8];
#pragma unroll
    for (int j = 0; j < 3; ++j)
#pragma unroll
        for (int q = 0; q < 8; ++q) { const int ch = 8 * F.lane + 512 * j + q; w0[j][q] = cw[ch]; w1[j][q] = cw[1536 + ch]; w2[j][q] = cw[3072 + ch]; bb[j][q] = cb[ch]; }
    for (int r = gw; r < T; r += NGW) {
        int l, L; if (r < TL) { l = r & 2047; L = SEQ; } else { l = (r - TL) & 255; L = CTXL; }
        const bool hp = l > 0, hn = l < L - 1;
#pragma unroll
        for (int j = 0; j < 3; ++j) { const int ch = 8 * F.lane + 512 * j;
            const u32x4 z4 = (u32x4){0u, 0u, 0u, 0u};
            const u32x4 xm = *(const u32x4*)(XBC + (size_t)r * 1536 + ch);
            const u32x4 xp = hp ? *(const u32x4*)(XBC + (size_t)(r - 1) * 1536 + ch) : z4;
            const u32x4 xn = hn ? *(const u32x4*)(XBC + (size_t)(r + 1) * 1536 + ch) : z4;
            float fm[8], fp[8], fn[8], o[8]; unpack8(xm, fm); unpack8(xp, fp); unpack8(xn, fn);
#pragma unroll
            for (int q = 0; q < 8; ++q) { const float v = bb[j][q] + w0[j][q] * fp[q] + w1[j][q] * fm[q] + w2[j][q] * fn[q]; o[q] = siluf_(v); }
            *(u32x4*)(XC + (size_t)r * 1536 + ch) = pack8(o); }
    }
}
__device__ __forceinline__ void phase_ssd_out(Frame& F, const Args& a) {
    const int gw = F.bid * NWAVES + F.wave, NGW = F.G * NWAVES;
    const bf16_t* Y0 = (const bf16_t*)(F.ws + WSLOT(4)); const bf16_t* Y1 = Y0 + (size_t)T * 1024;
    const bf16_t* Z = (const bf16_t*)(F.ws + WSLOT(1)); const bf16_t* XC = (const bf16_t*)(F.ws + WSLOT(3)); bf16_t* MIX = (bf16_t*)(F.ws + WSLOT(5));
    const int g = gw & 1, ch = g * 512 + 8 * F.lane;
    const float dh = a.in[13][ch >> 6];
    float nwv[8];
#pragma unroll
    for (int q = 0; q < 8; ++q) nwv[q] = a.in[14][ch + q];
    for (int it0 = gw; it0 < 2 * T; it0 += 2 * NGW) {
        u32x4 q[2][4];
#pragma unroll
        for (int u = 0; u < 2; ++u) { const int it = it0 + u * NGW; if (it < 2 * T) { const int r = it >> 1;
            q[u][0] = NTL((const u32x4*)(Y0 + (size_t)r * 1024 + ch)); q[u][1] = NTL((const u32x4*)(Y1 + (size_t)r * 1024 + ch));
            q[u][2] = NTL((const u32x4*)(Z + (size_t)r * 1024 + ch)); q[u][3] = NTL((const u32x4*)(XC + (size_t)r * 1536 + ch)); } }
#pragma unroll
        for (int u = 0; u < 2; ++u) { const int it = it0 + u * NGW; if (it < 2 * T) { const int r = it >> 1;
            float y0[8], y1[8], z[8], xs[8], uu[8];
            unpack8(q[u][0], y0); unpack8(q[u][1], y1); unpack8(q[u][2], z); unpack8(q[u][3], xs);
            float ss = 0.f;
#pragma unroll
            for (int x = 0; x < 8; ++x) { uu[x] = (y0[x] + y1[x] + dh * xs[x]) * siluf_(z[x]); ss += uu[x] * uu[x]; }
            ss = wave_sum(ss);
            const float rs = rsqrtf(ss * (1.f / 512.f) + LN_EPS);
#pragma unroll
            for (int x = 0; x < 8; ++x) uu[x] = uu[x] * rs * nwv[x];
            u32x2 p; p.x = pk4_f8(uu[0], uu[1], uu[2], uu[3]); p.y = pk4_f8(uu[4], uu[5], uu[6], uu[7]); *(u32x2*)((unsigned char*)MIX + (size_t)r * D + ch) = p; } }
    }
}
__device__ __forceinline__ void phase_ln_mid(Frame& F, const Args& a, int layer, int nrows, const bf16_t* V, bf16_t* X1, bf16_t* H, unsigned char* H8) {
    const int gw = F.bid * NWAVES + F.wave, NGW = F.G * NWAVES;
    const float* MOD = (const float*)(F.ws + WS_MOD) + (size_t)layer * 17 * 12288;
    const float* lg = a.in[6] + (size_t)(layer * 2 + 0) * D; const float* lb = a.in[7] + (size_t)(layer * 2 + 0) * D;
    const int rpw = (nrows + NGW - 1) / NGW, r0 = gw * rpw, r1 = (r0 + rpw < nrows) ? r0 + rpw : nrows;
    f32x4 lgv[4][2], lbv[4][2], scv[4][2], shv[4][2]; int cur = -1;
#pragma unroll
    for (int j = 0; j < 4; ++j)
#pragma unroll
        for (int h = 0; h < 2; ++h) { lgv[j][h] = *(const f32x4*)(lg + LNC(j) + 4 * h); lbv[j][h] = *(const f32x4*)(lb + LNC(j) + 4 * h); }
    for (int rb = r0; rb < r1; rb += 2) {
      u32x4 raw[2][4];
#pragma unroll
      for (int u = 0; u < 2; ++u) if (rb + u < r1) {
#pragma unroll
          for (int j = 0; j < 4; ++j) raw[u][j] = NTL((const u32x4*)(V + (size_t)(rb + u) * D + LNC(j))); }
#pragma unroll
      for (int u = 0; u < 2; ++u) { const int r = rb + u; if (r >= r1) break;
        u32x4 cu[4];
#pragma unroll
        for (int j = 0; j < 4; ++j) cu[j] = raw[u][j];
        const int mr = r < TL ? (r >> 11) : 16;
        if (mr != cur) { cur = mr; const float* sh = MOD + (size_t)mr * 12288 + 3 * 2048; const float* sc = sh + 2048;
#pragma unroll
            for (int j = 0; j < 4; ++j)
#pragma unroll
                for (int h = 0; h < 2; ++h) { const int c = LNC(j) + 4 * h; const f32x4 s1 = *(const f32x4*)(sc + c); shv[j][h] = *(const f32x4*)(sh + c);
                    scv[j][h].x = 1.f + s1.x; scv[j][h].y = 1.f + s1.y; scv[j][h].z = 1.f + s1.z; scv[j][h].w = 1.f + s1.w; } }
        f32x4 v[4][2]; float s = 0.f;
#pragma unroll
        for (int j = 0; j < 4; ++j) { const u32x4 p = cu[j];
            v[j][0].x = bflo(p.x); v[j][0].y = bfhi(p.x); v[j][0].z = bflo(p.y); v[j][0].w = bfhi(p.y); v[j][1].x = bflo(p.z); v[j][1].y = bfhi(p.z); v[j][1].z = bflo(p.w); v[j][1].w = bfhi(p.w);
#pragma unroll
            for (int h = 0; h < 2; ++h) s += (v[j][h].x + v[j][h].y) + (v[j][h].z + v[j][h].w); }
        const float mean = wave_sum(s) * (1.f / D); float s2 = 0.f;
#pragma unroll
        for (int j = 0; j < 4; ++j)
#pragma unroll
            for (int h = 0; h < 2; ++h) { v[j][h].x -= mean; v[j][h].y -= mean; v[j][h].z -= mean; v[j][h].w -= mean; s2 += (v[j][h].x * v[j][h].x + v[j][h].y * v[j][h].y) + (v[j][h].z * v[j][h].z + v[j][h].w * v[j][h].w); }
        const float rstd = rsqrtf(wave_sum(s2) * (1.f / D) + LN_EPS);
#pragma unroll
        for (int j = 0; j < 4; ++j) { f32x4 y[2], hh[2];
#pragma unroll
            for (int h = 0; h < 2; ++h) {
                y[h].x = v[j][h].x * rstd * lgv[j][h].x + lbv[j][h].x; y[h].y = v[j][h].y * rstd * lgv[j][h].y + lbv[j][h].y; y[h].z = v[j][h].z * rstd * lgv[j][h].z + lbv[j][h].z; y[h].w = v[j][h].w * rstd * lgv[j][h].w + lbv[j][h].w;
                hh[h].x = y[h].x * scv[j][h].x + shv[j][h].x; hh[h].y = y[h].y * scv[j][h].y + shv[j][h].y; hh[h].z = y[h].z * scv[j][h].z + shv[j][h].z; hh[h].w = y[h].w * scv[j][h].w + shv[j][h].w; }
            st_bf16x8(X1 + (size_t)r * D + LNC(j), y[0], y[1]);
            { u32x2 o8; o8.x = pk4_f8(hh[0].x, hh[0].y, hh[0].z, hh[0].w); o8.y = pk4_f8(hh[1].x, hh[1].y, hh[1].z, hh[1].w); *(u32x2*)(H8 + (size_t)r * D + LNC(j)) = o8; } }
      }
    }
}
template <bool LAST>
__device__ __forceinline__ void phase_ln_final(Frame& F, const Args& a, int layer, int nrows, const bf16_t* X1, const bf16_t* YBb, bf16_t* X2, bf16_t* H) {
    const unsigned char* YB = (const unsigned char*)YBb;
    const int gw = F.bid * NWAVES + F.wave, NGW = F.G * NWAVES;
    const float* MOD = (const float*)(F.ws + WS_MOD) + (size_t)layer * 17 * 12288;
    const float* lg = a.in[6] + (size_t)(layer * 2 + 1) * D; const float* lb = a.in[7] + (size_t)(layer * 2 + 1) * D;
    const int* RT = (const int*)(F.ws + WS_ROUTE);
    const int rpw = (nrows + NGW - 1) / NGW, r0 = gw * rpw, r1 = (r0 + rpw < nrows) ? r0 + rpw : nrows;
    f32x4 lgv[4][2], lbv[4][2], gtv[4][2]; int cur = -1;
#pragma unroll
    for (int j = 0; j < 4; ++j)
#pragma unroll
        for (int h = 0; h < 2; ++h) { lgv[j][h] = *(const f32x4*)(lg + LNC(j) + 4 * h); lbv[j][h] = *(const f32x4*)(lb + LNC(j) + 4 * h); }
    const int r1s = __builtin_amdgcn_readfirstlane(r1);
    for (int rb = __builtin_amdgcn_readfirstlane(r0); rb < r1s; rb += 2) {
        int p0[2], p1[2]; float w0[2], w1[2]; u32x4 qx[2][4]; u32x2 qa[2][4], qb[2][4];
#pragma unroll
        for (int u = 0; u < 2; ++u) { const int r = (rb + u < r1s) ? rb + u : rb;
            p0[u] = RT[(size_t)r * 4 + 0]; p1[u] = RT[(size_t)r * 4 + 1]; w0[u] = __int_as_float(RT[(size_t)r * 4 + 2]); w1[u] = __int_as_float(RT[(size_t)r * 4 + 3]); }
#pragma unroll
        for (int u = 0; u < 2; ++u) { const int r = (rb + u < r1s) ? rb + u : rb;
#pragma unroll
            for (int j = 0; j < 4; ++j) { qx[u][j] = NTL((const u32x4*)(X1 + (size_t)r * D + LNC(j))); qa[u][j] = NTL((const u32x2*)(YB + (size_t)p0[u] * D + LNC(j))); qb[u][j] = NTL((const u32x2*)(YB + (size_t)p1[u] * D + LNC(j))); } }
#pragma unroll
        for (int u = 0; u < 2; ++u) { const int r = rb + u; if (r >= r1s) break;
        const int mr = r < TL ? (r >> 11) : 16;
        if (mr != cur) { cur = mr; const float* gt = MOD + (size_t)mr * 12288 + 5 * 2048;
#pragma unroll
            for (int j = 0; j < 4; ++j) { gtv[j][0] = *(const f32x4*)(gt + LNC(j)); gtv[j][1] = *(const f32x4*)(gt + LNC(j) + 4); } }
        const float ww0 = w0[u], ww1 = w1[u];
        f32x4 v[4][2]; float s = 0.f;
#pragma unroll
        for (int j = 0; j < 4; ++j) { float xx[8], ya[8], yb[8];
            unpack8(qx[u][j], xx); unpack8_f8(qa[u][j], ya); unpack8_f8(qb[u][j], yb);
#pragma unroll
            for (int h = 0; h < 2; ++h) { const f32x4 g4 = gtv[j][h];
                v[j][h].x = ALPHA * xx[4 * h + 0] + g4.x * (ww0 * ya[4 * h + 0] + ww1 * yb[4 * h + 0]);
                v[j][h].y = ALPHA * xx[4 * h + 1] + g4.y * (ww0 * ya[4 * h + 1] + ww1 * yb[4 * h + 1]);
                v[j][h].z = ALPHA * xx[4 * h + 2] + g4.z * (ww0 * ya[4 * h + 2] + ww1 * yb[4 * h + 2]);
                v[j][h].w = ALPHA * xx[4 * h + 3] + g4.w * (ww0 * ya[4 * h + 3] + ww1 * yb[4 * h + 3]);
                s += (v[j][h].x + v[j][h].y) + (v[j][h].z + v[j][h].w); } }
        const float mean = wave_sum(s) * (1.f / D); float s2 = 0.f;
#pragma unroll
        for (int j = 0; j < 4; ++j)
#pragma unroll
            for (int h = 0; h < 2; ++h) { v[j][h].x -= mean; v[j][h].y -= mean; v[j][h].z -= mean; v[j][h].w -= mean; s2 += (v[j][h].x * v[j][h].x + v[j][h].y * v[j][h].y) + (v[j][h].z * v[j][h].z + v[j][h].w * v[j][h].w); }
        const float rstd = rsqrtf(wave_sum(s2) * (1.f / D) + LN_EPS);
#pragma unroll
        for (int j = 0; j < 4; ++j) { f32x4 y[2];
#pragma unroll
            for (int h = 0; h < 2; ++h) { y[h].x = v[j][h].x * rstd * lgv[j][h].x + lbv[j][h].x; y[h].y = v[j][h].y * rstd * lgv[j][h].y + lbv[j][h].y; y[h].z = v[j][h].z * rstd * lgv[j][h].z + lbv[j][h].z; y[h].w = v[j][h].w * rstd * lgv[j][h].w + lbv[j][h].w; }
            if (LAST) { NTS(y[0], (f32x4*)(F.out + (size_t)r * D + LNC(j))); NTS(y[1], (f32x4*)(F.out + (size_t)r * D + LNC(j) + 4)); }
            else st_bf16x8(X2 + (size_t)r * D + LNC(j), y[0], y[1]); }
        }
    }
}

__device__ __forceinline__ void phase_ssd_scan(Frame& F, const Args& a) {
    const bf16_t* XC = (const bf16_t*)(F.ws + WSLOT(3)); const float* DT = (const float*)(F.ws + WS_DT);
    bf16_t* Y = (bf16_t*)(F.ws + WSLOT(4));
    LAS bf16_t* xs = (LAS bf16_t*)F.lds;
    LAS bf16_t* Bs = (LAS bf16_t*)(F.lds + 8192);
    LAS bf16_t* Cs = (LAS bf16_t*)(F.lds + 16384);
    LAS float* dts = (LAS float*)(F.lds + 24576);
    LAS float* ybuf = (LAS float*)(F.lds + 32768);
    const int t = F.tid, team = t >> 8, tt = t & 255, pi = tt >> 4, ni = tt & 15;
    const int si = t >> 4, sp = t & 15;
    for (int unit = F.bid; unit < 256; unit += F.G) {
        const int b = unit >> 4, dir = (unit >> 3) & 1, hp = unit & 7, g = hp >> 2, h = 2 * hp + team;
        const float Ah = -__expf(a.in[11][dir * 16 + h]);
        float S[4][8];
#pragma unroll
        for (int j = 0; j < 4; ++j)
#pragma unroll
            for (int i = 0; i < 8; ++i) S[j][i] = 0.f;
        u32x4 px, pb, pc; float pdt = 0.f;
        auto load_chunk = [&](int chunk) {
            int L, base, c0; if (chunk < 8) { L = CTXL; base = TL + b * CTXL; c0 = chunk * 32; } else { L = SEQ; base = b * SEQ; c0 = (chunk - 8) * 32; }
            const int s = c0 + si; const size_t row = (size_t)(base + (dir ? (L - 1 - s) : s));
            px = *(const u32x4*)(XC + row * 1536 + hp * 128 + sp * 8);
            pb = *(const u32x4*)(XC + row * 1536 + 1024 + g * 128 + sp * 8);
            pc = *(const u32x4*)(XC + row * 1536 + 1280 + g * 128 + sp * 8);
            if (t < 64) { const int i2 = t >> 1, hh = t & 1; const int s2 = c0 + i2; const size_t row2 = (size_t)(base + (dir ? (L - 1 - s2) : s2)); pdt = DT[row2 * 32 + dir * 16 + 2 * hp + hh]; }
        };
        load_chunk(0);
        for (int chunk = 0; chunk < 72; ++chunk) {
            __syncthreads();
            *(LAS u32x4*)(xs + si * 128 + sp * 8) = px; *(LAS u32x4*)(Bs + si * 128 + sp * 8) = pb; *(LAS u32x4*)(Cs + si * 128 + sp * 8) = pc;
            if (t < 64) dts[t] = pdt;
            __syncthreads();
            if (chunk + 1 < 72) load_chunk(chunk + 1);
#pragma unroll 2
            for (int s = 0; s < 32; ++s) {
                const float dtv = dts[s * 2 + team]; const float dec = __expf(dtv * Ah);
                const u32x2 xr = *(const LAS u32x2*)(xs + s * 128 + team * 64 + pi * 4);
                float Bv[8], Cv[8]; unpack8(*(const LAS u32x4*)(Bs + s * 128 + ni * 8), Bv); unpack8(*(const LAS u32x4*)(Cs + s * 128 + ni * 8), Cv);
                float xv[4]; xv[0] = bflo(xr.x) * dtv; xv[1] = bfhi(xr.x) * dtv; xv[2] = bflo(xr.y) * dtv; xv[3] = bfhi(xr.y) * dtv;
                float yp[4];
#pragma unroll
                for (int j = 0; j < 4; ++j) { float acc = 0.f;
#pragma unroll
                    for (int i = 0; i < 8; ++i) { S[j][i] = fmaf(xv[j], Bv[i], S[j][i] * dec); acc = fmaf(S[j][i], Cv[i], acc); }
                    yp[j] = row16_sum(acc); }
                const float ysel = ni == 0 ? yp[0] : (ni == 1 ? yp[1] : (ni == 2 ? yp[2] : yp[3]));
                if (ni < 4) ybuf[s * 128 + team * 64 + pi * 4 + ni] = ysel;
            }
            __syncthreads();
            {   int L, base, c0; if (chunk < 8) { L = CTXL; base = TL + b * CTXL; c0 = chunk * 32; } else { L = SEQ; base = b * SEQ; c0 = (chunk - 8) * 32; }
                const int s = c0 + si; const size_t row = (size_t)(base + (dir ? (L - 1 - s) : s));
                float o[8];
#pragma unroll
                for (int q = 0; q < 8; ++q) o[q] = ybuf[si * 128 + sp * 8 + q];
                *(u32x4*)(Y + (size_t)dir * T * 1024 + row * 1024 + hp * 128 + sp * 8) = pack8(o); }
        }
        __syncthreads();
    }
}


constexpr int LD_N = 136, LD_S = 72;
constexpr int SS_CM = 0;
constexpr int SS_BM = SS_CM + 64 * LD_N * 2;
constexpr int SS_BT = SS_BM + 64 * LD_N * 2;
constexpr int SS_XD = SS_BT + 128 * LD_S * 2;
constexpr int SS_XW = SS_XD + 128 * LD_S * 2;
constexpr int SS_MH = SS_XW + 128 * LD_S * 2;
constexpr int SS_SB = SS_MH + 128 * LD_S * 2;
constexpr int SS_DT = SS_SB + 128 * LD_N * 2;
constexpr int SS_AC = SS_DT + 512;
static_assert(SS_AC + 512 <= LDS_MISC, "SSD scratch overlaps the misc words");

__device__ __forceinline__ void mfma_settle(f32x4& a, f32x4& b, f32x4& c, f32x4& d) { asm volatile("s_nop 7\n\ts_nop 7" : "+v"(a), "+v"(b), "+v"(c), "+v"(d)); }
__device__ __forceinline__ bf16x8 ldfrag(const LAS bf16_t* P, int ld, int fr, int fq, int k) { return *(const LAS bf16x8*)(P + fr * ld + k * 32 + fq * 8); }
#define MFMA16(a_, b_, c_) __builtin_amdgcn_mfma_f32_16x16x32_bf16((a_), (b_), (c_), 0, 0, 0)
template <int KSTEPS>
__device__ __forceinline__ f32x4 mma16(const LAS bf16_t* A, int lda, const LAS bf16_t* Bt, int ldb, f32x4 acc, int fr, int fq) {
#pragma unroll
    for (int k = 0; k < KSTEPS; ++k) {
        const bf16x8 av = *(const LAS bf16x8*)(A + fr * lda + k * 32 + fq * 8);
        const bf16x8 bv = *(const LAS bf16x8*)(Bt + fr * ldb + k * 32 + fq * 8);
        acc = __builtin_amdgcn_mfma_f32_16x16x32_bf16(av, bv, acc, 0, 0, 0);
    }
    return acc;
}

__device__ __forceinline__ void phase_ssd_chunked(Frame& F, const Args& a) {
    const bf16_t* XC = (const bf16_t*)(F.ws + WSLOT(3)); const float* DT = (const float*)(F.ws + WS_DT);
    bf16_t* Y = (bf16_t*)(F.ws + WSLOT(4));
    LAS bf16_t* Cm = (LAS bf16_t*)(F.lds + SS_CM); LAS bf16_t* Bm = (LAS bf16_t*)(F.lds + SS_BM); LAS bf16_t* BT = (LAS bf16_t*)(F.lds + SS_BT);
    LAS bf16_t* XdT = (LAS bf16_t*)(F.lds + SS_XD); LAS bf16_t* XwT = (LAS bf16_t*)(F.lds + SS_XW); LAS bf16_t* Mh = (LAS bf16_t*)(F.lds + SS_MH);
    LAS bf16_t* Sb = (LAS bf16_t*)(F.lds + SS_SB); LAS float* dtl = (LAS float*)(F.lds + SS_DT); LAS float* acl = (LAS float*)(F.lds + SS_AC);
    const int t = F.tid, w = F.wave, lane = F.lane, fr = lane & 15, fq = lane >> 4;
    const int j16 = t >> 5, s0 = t & 31;
    const int hh = w >> 2;
    for (int unit = F.bid; unit < 256; unit += F.G) {
        const int b = unit >> 4, dir = (unit >> 3) & 1, hp = unit & 7, g = hp >> 2;
        const float A0 = -__expf(a.in[11][dir * 16 + 2 * hp]), A1 = -__expf(a.in[11][dir * 16 + 2 * hp + 1]);
        f32x4 sacc[2][4];
#pragma unroll
        for (int i = 0; i < 2; ++i)
#pragma unroll
            for (int j = 0; j < 4; ++j) sacc[i][j] = (f32x4){0.f, 0.f, 0.f, 0.f};
        u32x4 pc[2], pb[2], px[2]; float pdt = 0.f;
#define SSD_LOAD(chunk_) do { int L_, base_, c0_; if ((chunk_) < 4) { L_ = CTXL; base_ = TL + b * CTXL; c0_ = (chunk_) * 64; } else { L_ = SEQ; base_ = b * SEQ; c0_ = ((chunk_) - 4) * 64; } \
            _Pragma("unroll") for (int hf = 0; hf < 2; ++hf) { const int s_ = c0_ + s0 + 32 * hf; const size_t row_ = (size_t)(base_ + (dir ? (L_ - 1 - s_) : s_)); \
                pc[hf] = *(const u32x4*)(XC + row_ * 1536 + 1280 + g * 128 + 8 * j16); pb[hf] = *(const u32x4*)(XC + row_ * 1536 + 1024 + g * 128 + 8 * j16); \
                px[hf] = *(const u32x4*)(XC + row_ * 1536 + hp * 128 + 8 * j16); } \
            if (t < 128) { const int s_ = c0_ + (t & 63); const size_t row_ = (size_t)(base_ + (dir ? (L_ - 1 - s_) : s_)); pdt = DT[row_ * 32 + dir * 16 + 2 * hp + (t >> 6)]; } } while (0)
        SSD_LOAD(0);
        for (int chunk = 0; chunk < 36; ++chunk) {
            __syncthreads();
            mfma_settle(sacc[0][0], sacc[0][1], sacc[0][2], sacc[0][3]); mfma_settle(sacc[1][0], sacc[1][1], sacc[1][2], sacc[1][3]);
#pragma unroll
            for (int i = 0; i < 2; ++i)
#pragma unroll
                for (int j = 0; j < 4; ++j) { const int n0 = 16 * (2 * (w & 3) + i) + 4 * fq, p = 16 * j + fr;
                    u32x2 o; o.x = pk2(sacc[i][j].x, sacc[i][j].y); o.y = pk2(sacc[i][j].z, sacc[i][j].w);
                    *(LAS u32x2*)(Sb + (hh * 64 + p) * LD_N + n0) = o; }
#pragma unroll
            for (int hf = 0; hf < 2; ++hf) { const int s = s0 + 32 * hf;
                *(LAS u32x4*)(Cm + s * LD_N + 8 * j16) = pc[hf]; *(LAS u32x4*)(Bm + s * LD_N + 8 * j16) = pb[hf];
                const unsigned bw[4] = {pb[hf].x, pb[hf].y, pb[hf].z, pb[hf].w};
#pragma unroll
                for (int x = 0; x < 4; ++x) { BT[(8 * j16 + 2 * x) * LD_S + s] = (bf16_t)(bw[x] & 0xffffu); BT[(8 * j16 + 2 * x + 1) * LD_S + s] = (bf16_t)(bw[x] >> 16); } }
            if (w < 2) { float v = pdt * (w ? A1 : A0);
#pragma unroll
                for (int o = 1; o < 64; o <<= 1) { const float u = __shfl_up(v, o); if (lane >= o) v += u; }
                dtl[w * 64 + lane] = pdt; acl[w * 64 + lane] = v; }
            __syncthreads();
#pragma unroll
            for (int hf = 0; hf < 2; ++hf) { const int s = s0 + 32 * hf, xh = j16 >> 3, pbase = (j16 & 7) * 8;
                const float dtv = dtl[xh * 64 + s], fw = __expf(acl[xh * 64 + 63] - acl[xh * 64 + s]);
                float xv[8]; unpack8(px[hf], xv);
#pragma unroll
                for (int x = 0; x < 8; ++x) { const float xd = xv[x] * dtv; const unsigned pkd = pk2(xd, xd * fw);
                    XdT[(xh * 64 + pbase + x) * LD_S + s] = (bf16_t)(pkd & 0xffffu); XwT[(xh * 64 + pbase + x) * LD_S + s] = (bf16_t)(pkd >> 16); } }
            if (chunk + 1 < 36) SSD_LOAD(chunk + 1);
            __syncthreads();
            {   const int st = w >> 1;
#pragma unroll
                for (int q = 0; q < 2; ++q) { const int lt = 2 * (w & 1) + q;
                    const f32x4 gv = mma16<4>(Bm + 16 * st * LD_N, LD_N, Cm + 16 * lt * LD_N, LD_N, (f32x4){0.f, 0.f, 0.f, 0.f}, fr, fq);
                    const int l = 16 * lt + fr, sb = 16 * st + 4 * fq;
#pragma unroll
                    for (int h2 = 0; h2 < 2; ++h2) { const float al = acl[h2 * 64 + l];
                        const float m0 = (sb + 0 <= l) ? gv.x * __expf(al - acl[h2 * 64 + sb + 0]) : 0.f;
                        const float m1 = (sb + 1 <= l) ? gv.y * __expf(al - acl[h2 * 64 + sb + 1]) : 0.f;
                        const float m2 = (sb + 2 <= l) ? gv.z * __expf(al - acl[h2 * 64 + sb + 2]) : 0.f;
                        const float m3 = (sb + 3 <= l) ? gv.w * __expf(al - acl[h2 * 64 + sb + 3]) : 0.f;
                        u32x2 o; o.x = pk2(m0, m1); o.y = pk2(m2, m3);
                        *(LAS u32x2*)(Mh + (h2 * 64 + l) * LD_S + sb) = o; } } }
            __syncthreads();
            {   const int lt = w & 3;
                f32x4 yacc[4];
#pragma unroll
                for (int pt = 0; pt < 4; ++pt) yacc[pt] = mma16<4>(Sb + (hh * 64 + 16 * pt) * LD_N, LD_N, Cm + 16 * lt * LD_N, LD_N, (f32x4){0.f, 0.f, 0.f, 0.f}, fr, fq);
                const float el = __expf(acl[hh * 64 + 16 * lt + fr]);
#pragma unroll
                for (int pt = 0; pt < 4; ++pt) { yacc[pt].x *= el; yacc[pt].y *= el; yacc[pt].z *= el; yacc[pt].w *= el;
                    yacc[pt] = mma16<2>(XdT + (hh * 64 + 16 * pt) * LD_S, LD_S, Mh + (hh * 64 + 16 * lt) * LD_S, LD_S, yacc[pt], fr, fq); }
                int L, base, c0; if (chunk < 4) { L = CTXL; base = TL + b * CTXL; c0 = chunk * 64; } else { L = SEQ; base = b * SEQ; c0 = (chunk - 4) * 64; }
                const int sidx = c0 + 16 * lt + fr; const size_t row = (size_t)(base + (dir ? (L - 1 - sidx) : sidx));
                bf16_t* Yd = Y + (size_t)dir * T * 1024 + (2 * hp + hh) * 64 + 4 * fq + row * 1024;
#pragma unroll
                for (int pt = 0; pt < 4; ++pt) { u32x2 o; o.x = pk2(yacc[pt].x, yacc[pt].y); o.y = pk2(yacc[pt].z, yacc[pt].w); *(u32x2*)(Yd + 16 * pt) = o; } }
            {   const float cd = __expf(acl[hh * 64 + 63]);
#pragma unroll
                for (int i = 0; i < 2; ++i)
#pragma unroll
                    for (int j = 0; j < 4; ++j) { sacc[i][j].x *= cd; sacc[i][j].y *= cd; sacc[i][j].z *= cd; sacc[i][j].w *= cd;
                        sacc[i][j] = mma16<2>(BT + 16 * (2 * (w & 3) + i) * LD_S, LD_S, XwT + (hh * 64 + 16 * j) * LD_S, LD_S, sacc[i][j], fr, fq); } }
        }
#undef SSD_LOAD
        __syncthreads();
    }
}

__device__ __forceinline__ void phase_route_count(Frame& F, const Args& a, int t0, int per, int ntok, unsigned* gcnt) {
    const float* LG = (const float*)(F.ws + WS_LOGIT); int* RT = (int*)(F.ws + WS_ROUTE); const float* bias = a.in[33];
    {   int* TOK = (int*)(F.ws + WS_TOK); for (int i = F.bid * NTHREADS + F.tid; i < 81920; i += F.G * NTHREADS) TOK[i] = 0; }
    LAS int* lcnt = (LAS int*)(F.lds); LAS int* lbase = lcnt + 32;
    const int tok = t0 + F.tid; const bool act = F.tid < per && tok < ntok;
    if (F.tid < 32) lcnt[F.tid] = 0;
    __syncthreads();
    int e0 = 0, e1 = 0, r0 = 0, r1 = 0; float w0 = 0.f, w1 = 0.f;
    if (act) {
        float s[32], ss[32];
#pragma unroll
        for (int q = 0; q < 8; ++q) { const f32x4 v = *(const f32x4*)(LG + (size_t)tok * 32 + 4 * q); s[4 * q] = sigmoidf_(v.x); s[4 * q + 1] = sigmoidf_(v.y); s[4 * q + 2] = sigmoidf_(v.z); s[4 * q + 3] = sigmoidf_(v.w); }
#pragma unroll
        for (int q = 0; q < 32; ++q) ss[q] = s[q] + bias[q];
        float best = -3.0e38f; int gsel = 0;
#pragma unroll
        for (int g = 0; g < 4; ++g) { float m1 = -3.0e38f, m2 = -3.0e38f;
#pragma unroll
            for (int q = 0; q < 8; ++q) { const float v = ss[g * 8 + q]; if (v > m1) { m2 = m1; m1 = v; } else if (v > m2) m2 = v; }
            const float gs = m1 + m2; if (gs > best) { best = gs; gsel = g; } }
        float m1 = -3.0e38f, m2 = -3.0e38f; int i1 = 0, i2 = 0; float s1 = 0.f, s2 = 0.f;
#pragma unroll
        for (int g = 0; g < 4; ++g)
#pragma unroll
            for (int q = 0; q < 8; ++q) { if (g == gsel) { const float v = ss[g * 8 + q]; const float sv = s[g * 8 + q];
                if (v > m1) { m2 = m1; i2 = i1; s2 = s1; m1 = v; i1 = g * 8 + q; s1 = sv; } else if (v > m2) { m2 = v; i2 = g * 8 + q; s2 = sv; } } }
        e0 = i1; e1 = i2; const float inv = 1.f / (s1 + s2); w0 = s1 * inv; w1 = s2 * inv;
        r0 = atomicAdd((int*)&lcnt[e0], 1); r1 = atomicAdd((int*)&lcnt[e1], 1);
    }
    __syncthreads();
    if (F.tid < 32) lbase[F.tid] = (int)atomicAdd(&gcnt[F.tid], (unsigned)lcnt[F.tid]);
    __syncthreads();
    if (act) { RT[(size_t)tok * 4 + 0] = (e0 << 24) | (lbase[e0] + r0); RT[(size_t)tok * 4 + 1] = (e1 << 24) | (lbase[e1] + r1);
        RT[(size_t)tok * 4 + 2] = __float_as_int(w0); RT[(size_t)tok * 4 + 3] = __float_as_int(w1); }
}
__device__ __forceinline__ void moe_tables(Frame& F, const unsigned* gcnt) {
    LAS int* tstart = (LAS int*)(F.lds + LDS_MISC + 256);
    if (F.tid == 0) { int acc = 0;
        for (int e = 0; e < 32; ++e) { tstart[e] = acc; const int c = (int)__hip_atomic_load(&gcnt[e], __ATOMIC_RELAXED, __HIP_MEMORY_SCOPE_AGENT); acc += (c + 255) >> 8; }
        tstart[32] = acc; }
    __syncthreads();
}
__device__ __forceinline__ void phase_route_scatter(Frame& F, int ntok, const unsigned* gcnt) {
    moe_tables(F, gcnt);
    const LAS int* tstart = (const LAS int*)(F.lds + LDS_MISC + 256);
    int* RT = (int*)(F.ws + WS_ROUTE); int* TOK = (int*)(F.ws + WS_TOK);
    for (int tok = F.bid * NTHREADS + F.tid; tok < ntok; tok += F.G * NTHREADS) {
        const int v0 = RT[(size_t)tok * 4 + 0], v1 = RT[(size_t)tok * 4 + 1];
        const int p0 = tstart[(v0 >> 24) & 31] * 256 + (v0 & 0xffffff), p1 = tstart[(v1 >> 24) & 31] * 256 + (v1 & 0xffffff);
        TOK[p0] = tok; TOK[p1] = tok; RT[(size_t)tok * 4 + 0] = p0; RT[(size_t)tok * 4 + 1] = p1;
    }
}

__device__ __forceinline__ void phase_mixes6(Frame& F, const Args& a, const bf16_t* X2, unsigned char* OB) {
    const size_t gt = (size_t)F.bid * NTHREADS + F.tid, NGT = (size_t)F.G * NTHREADS;
    const float* mu = a.in[16];
    const float* MOD1 = (const float*)(F.ws + WS_MOD) + (size_t)17 * 12288;
    const int c = (int)(gt & 255) * 8, q = __builtin_amdgcn_readfirstlane(c >> 9);
    float m[6][8], sc8[8], sh8[8]; int cur = -1;
    constexpr int MUI[6] = {0, 2, 3, 1, 4, 5};
#pragma unroll
    for (int i = 0; i < 6; ++i)
#pragma unroll
        for (int x = 0; x < 8; ++x) m[i][x] = mu[MUI[i] * D + c + x];
    for (size_t base0 = (size_t)F.bid * NTHREADS; base0 < (size_t)T * 256; base0 += 4 * NGT) {
        u32x4 hq[4], nq[4]; int rr[4];
#pragma unroll
        for (int u = 0; u < 4; ++u) { const size_t base = base0 + (size_t)u * NGT; rr[u] = -1; hq[u] = (u32x4){0u, 0u, 0u, 0u}; nq[u] = (u32x4){0u, 0u, 0u, 0u};
            if (base < (size_t)T * 256) { const int r = __builtin_amdgcn_readfirstlane((int)((base + F.tid) >> 8)); rr[u] = r;
                int nb = -1;
                if (r < TL) { const int l = r & 2047;
                    if (q == 0) { if ((l & 63) >= 1) nb = r - 1; } else if (q == 1) { if ((l & 63) <= 62) nb = r + 1; }
                    else if (q == 2) { if (l >= 64) nb = r - 64; } else { if (l < SEQ - 64) nb = r + 64; } }
                else { const int l = (r - TL) & 255;
                    if (q == 0 || q == 2) { if (l >= 1) nb = r - 1; } else { if (l <= CTXL - 2) nb = r + 1; } }
                hq[u] = *(const u32x4*)(X2 + (size_t)r * D + c);
                nq[u] = *(const u32x4*)(X2 + (size_t)(nb >= 0 ? nb : r) * D + c);
                if (nb < 0) rr[u] |= 0x40000000; } }
#pragma unroll
        for (int u = 0; u < 4; ++u) { if (rr[u] < 0) continue;
            const int r = rr[u] & 0x3fffffff; const bool has_nb = !(rr[u] & 0x40000000);
            const int mr = r < TL ? (r >> 11) : 16;
            if (mr != cur) { cur = mr; const float* sh = MOD1 + (size_t)mr * 12288 + c; const float* sc = sh + 2048;
                const f32x4 a0 = *(const f32x4*)sh, a1 = *(const f32x4*)(sh + 4), b0 = *(const f32x4*)sc, b1 = *(const f32x4*)(sc + 4);
                sh8[0] = a0.x; sh8[1] = a0.y; sh8[2] = a0.z; sh8[3] = a0.w; sh8[4] = a1.x; sh8[5] = a1.y; sh8[6] = a1.z; sh8[7] = a1.w;
                sc8[0] = 1.f + b0.x; sc8[1] = 1.f + b0.y; sc8[2] = 1.f + b0.z; sc8[3] = 1.f + b0.w; sc8[4] = 1.f + b1.x; sc8[5] = 1.f + b1.y; sc8[6] = 1.f + b1.z; sc8[7] = 1.f + b1.w; }
            float h[8], hn[8];
            unpack8(hq[u], h); unpack8(nq[u], hn);
#pragma unroll
            for (int x = 0; x < 8; ++x) { h[x] = h[x] * sc8[x] + sh8[x]; hn[x] = has_nb ? (hn[x] * sc8[x] + sh8[x] - h[x]) : -h[x]; }
#pragma unroll
            for (int i = 0; i < 6; ++i) { float o[8];
#pragma unroll
                for (int x = 0; x < 8; ++x) o[x] = h[x] + hn[x] * m[i][x];
                u32x2 p; p.x = pk4_f8(o[0], o[1], o[2], o[3]); p.y = pk4_f8(o[4], o[5], o[6], o[7]);
                *(u32x2*)(OB + (size_t)(i % 3) * SLOT + (size_t)(i / 3) * T * D + (size_t)r * D + c) = p; } }
    }
}
__device__ __forceinline__ void phase_kknorm(Frame& F, const Args& a, const bf16_t* Kb) {
    const int gw = F.bid * NWAVES + F.wave, NGW = F.G * NWAVES;
    float* INVN = (float*)(F.ws + WS_INVN); const float* kk_c = a.in[27];
    float kkv[4][8];
#pragma unroll
    for (int j = 0; j < 4; ++j)
#pragma unroll
        for (int x = 0; x < 8; ++x) kkv[j][x] = kk_c[8 * F.lane + 512 * j + x];
    for (int r = gw; r < T; r += NGW) {
#pragma unroll
        for (int j = 0; j < 4; ++j) { const int c = 8 * F.lane + 512 * j; float k[8]; unpack8(*(const u32x4*)(Kb + (size_t)r * D + c), k); float ss = 0.f;
#pragma unroll
            for (int x = 0; x < 8; ++x) { const float v = k[x] * kkv[j][x]; ss += v * v; }
            ss = grp8_sum(ss);
            if ((F.lane & 7) == 0) INVN[(size_t)r * 32 + (c >> 6)] = 1.f / fmaxf(sqrtf(ss), 1e-12f); }
    }
}
template <bool WRITE>
__device__ __forceinline__ void phase_wkv_scan(Frame& F, const Args& a, const bf16_t* Rb, const bf16_t* Kb, const bf16_t* Vb, const bf16_t* Q0, const bf16_t* Q1, bf16_t* A0, bf16_t* A1) {
    LAS float* st = (LAS float*)F.lds;
    LAS float* ybuf = (LAS float*)(F.lds + 98304);
    const float* INVN = (const float*)(F.ws + WS_INVN);
    const int t = F.tid, w = F.wave, hh = w >> 1, half = w & 1, i = F.lane >> 3, jj = F.lane & 7;
    const int sst = t >> 5, cg = t & 31, hs = cg >> 3, cs = (cg & 7) * 8;
    for (int unit = F.bid; unit < 256; unit += F.G) {
        const int e = unit >> 7, b = (unit >> 3) & 15, j4 = unit & 7, col0 = j4 * 256;
        const bf16_t* Qe = e ? +Q1 : +Q0; bf16_t* Ae = e ? +A1 : +A0;
        float kkc[8], kac[8], w0c[8], a0c[8];
#pragma unroll
        for (int x = 0; x < 8; ++x) { kkc[x] = a.in[27][col0 + cg * 8 + x]; kac[x] = a.in[28][col0 + cg * 8 + x];
            w0c[x] = a.in[19][e * D + col0 + cg * 8 + x]; a0c[x] = a.in[22][e * D + col0 + cg * 8 + x]; }
        float S[4][8];
#pragma unroll
        for (int j = 0; j < 4; ++j)
#pragma unroll
            for (int x = 0; x < 8; ++x) S[j][x] = 0.f;
        u32x4 pr, pk, pv, pq, pa; float pin = 0.f; size_t prow = 0;
        auto load_chunk = [&](int ci) {
            int L, base, s0; if (ci < 16) { L = CTXL; base = TL + b * CTXL; s0 = ci * 16; } else { L = SEQ; base = b * SEQ; s0 = (ci - 16) * 16; }
            const int s = s0 + sst; const size_t row = (size_t)(base + (e ? (L - 1 - s) : s)); const size_t off = row * D + col0 + cg * 8;
            pr = *(const u32x4*)(Rb + off); pk = *(const u32x4*)(Kb + off); pv = *(const u32x4*)(Vb + off); pq = *(const u32x4*)(Qe + off); pa = *(const u32x4*)(Ae + off);
            pin = INVN[row * 32 + j4 * 4 + hs]; prow = row;
        };
        load_chunk(0);
        for (int ci = 0; ci < 144; ++ci) {
            __syncthreads();
            const size_t crow = prow;
            {   float r8[8], k8[8], v8[8], q8[8], a8[8]; unpack8(pr, r8); unpack8(pk, k8); unpack8(pv, v8); unpack8(pq, q8); unpack8(pa, a8);
                float kk8[8], w8[8], b8[8], kd8[8];
#pragma unroll
                for (int x = 0; x < 8; ++x) { kk8[x] = k8[x] * kkc[x] * pin;
                    w8[x] = __expf(-0.6065306597f * sigmoidf_(w0c[x] + q8[x]));
                    const float av = sigmoidf_(a0c[x] + a8[x]);
                    b8[x] = kk8[x] * av; kd8[x] = k8[x] * (1.f + (av - 1.f) * kac[x]); }
                LAS float* dst = st + ((sst * 4 + hs) * 6) * 64 + cs;
                *(LAS f32x4*)(dst + 0 * 64) = (f32x4){r8[0], r8[1], r8[2], r8[3]};   *(LAS f32x4*)(dst + 0 * 64 + 4) = (f32x4){r8[4], r8[5], r8[6], r8[7]};
                *(LAS f32x4*)(dst + 1 * 64) = (f32x4){kk8[0], kk8[1], kk8[2], kk8[3]}; *(LAS f32x4*)(dst + 1 * 64 + 4) = (f32x4){kk8[4], kk8[5], kk8[6], kk8[7]};
                *(LAS f32x4*)(dst + 2 * 64) = (f32x4){w8[0], w8[1], w8[2], w8[3]};   *(LAS f32x4*)(dst + 2 * 64 + 4) = (f32x4){w8[4], w8[5], w8[6], w8[7]};
                *(LAS f32x4*)(dst + 3 * 64) = (f32x4){b8[0], b8[1], b8[2], b8[3]};   *(LAS f32x4*)(dst + 3 * 64 + 4) = (f32x4){b8[4], b8[5], b8[6], b8[7]};
                *(LAS f32x4*)(dst + 4 * 64) = (f32x4){kd8[0], kd8[1], kd8[2], kd8[3]}; *(LAS f32x4*)(dst + 4 * 64 + 4) = (f32x4){kd8[4], kd8[5], kd8[6], kd8[7]};
                *(LAS f32x4*)(dst + 5 * 64) = (f32x4){v8[0], v8[1], v8[2], v8[3]};   *(LAS f32x4*)(dst + 5 * 64 + 4) = (f32x4){v8[4], v8[5], v8[6], v8[7]}; }
            __syncthreads();
            if (ci + 1 < 144) load_chunk(ci + 1);
#pragma unroll 2
            for (int s = 0; s < 16; ++s) {
                const LAS float* p = st + ((s * 4 + hh) * 6) * 64 + jj * 8;
                const f32x4 r0 = *(const LAS f32x4*)(p), r1 = *(const LAS f32x4*)(p + 4);
                const f32x4 k0 = *(const LAS f32x4*)(p + 64), k1 = *(const LAS f32x4*)(p + 68);
                const f32x4 w0 = *(const LAS f32x4*)(p + 128), w1 = *(const LAS f32x4*)(p + 132);
                const f32x4 b0 = *(const LAS f32x4*)(p + 192), b1 = *(const LAS f32x4*)(p + 196);
                const f32x4 d0 = *(const LAS f32x4*)(p + 256), d1 = *(const LAS f32x4*)(p + 260);
                const f32x4 vv = *(const LAS f32x4*)(st + ((s * 4 + hh) * 6 + 5) * 64 + half * 32 + i * 4);
                const float rr[8] = {r0.x, r0.y, r0.z, r0.w, r1.x, r1.y, r1.z, r1.w}, kk[8] = {k0.x, k0.y, k0.z, k0.w, k1.x, k1.y, k1.z, k1.w};
                const float ww[8] = {w0.x, w0.y, w0.z, w0.w, w1.x, w1.y, w1.z, w1.w}, bb[8] = {b0.x, b0.y, b0.z, b0.w, b1.x, b1.y, b1.z, b1.w};
                const float kd[8] = {d0.x, d0.y, d0.z, d0.w, d1.x, d1.y, d1.z, d1.w}, vr[4] = {vv.x, vv.y, vv.z, vv.w};
                float yo[4];
#pragma unroll
                for (int j = 0; j < 4; ++j) { float sa = 0.f;
#pragma unroll
                    for (int x = 0; x < 8; ++x) sa = fmaf(S[j][x], kk[x], sa);
                    sa = -row8_sum(sa); float yacc = 0.f;
#pragma unroll
                    for (int x = 0; x < 8; ++x) { S[j][x] = fmaf(vr[j], kd[x], fmaf(sa, bb[x], S[j][x] * ww[x])); yacc = fmaf(S[j][x], rr[x], yacc); }
                    yo[j] = row8_sum(yacc); }
                const float ysel = jj == 0 ? yo[0] : (jj == 1 ? yo[1] : (jj == 2 ? yo[2] : yo[3]));
                if (jj < 4) ybuf[s * 256 + hh * 64 + half * 32 + i * 4 + jj] = ysel;
            }
            __syncthreads();
            if (WRITE && ci >= 16) { float o[8];
#pragma unroll
                for (int x = 0; x < 8; ++x) o[x] = ybuf[sst * 256 + cg * 8 + x];
                *(u32x4*)(Ae + crow * D + col0 + cg * 8) = pack8(o); }
        }
        __syncthreads();
    }
}

constexpr int WK_AT = 0, WK_RT = 2304, WK_BD = 4608, WK_BDT = 9216, WK_PVT = 14336, WK_LM = 19456, WK_LADM = 20736, WK_LAB = 22016, WK_RHS = 23040, WK_WC = 27136, WK_SB = 27392, WK_RAW2 = 36608, WK_HEAD = 40704;
constexpr int WK_RAW1 = WK_LADM;
static_assert(4 * WK_HEAD <= LDS_MISC, "WKV scratch overlaps the misc words");

__device__ __forceinline__ void phase_wkv_chunked(Frame& F, const Args& a, const bf16_t* Rb, const bf16_t* Kb, const bf16_t* Vb, const bf16_t* Q0, const bf16_t* Q1, bf16_t* A0, bf16_t* A1) {
    const int w = F.wave, lane = F.lane, fr = lane & 15, fq = lane >> 4, hh = w & 3, role = w >> 2;
    LAS unsigned char* hb = F.lds + hh * WK_HEAD;
    LAS bf16_t* AT = (LAS bf16_t*)(hb + WK_AT); LAS bf16_t* RT = (LAS bf16_t*)(hb + WK_RT); LAS bf16_t* BD = (LAS bf16_t*)(hb + WK_BD);
    LAS bf16_t* BDT = (LAS bf16_t*)(hb + WK_BDT); LAS bf16_t* PVT = (LAS bf16_t*)(hb + WK_PVT); LAS bf16_t* LM = (LAS bf16_t*)(hb + WK_LM);
    LAS bf16_t* LADM = (LAS bf16_t*)(hb + WK_LADM); LAS float* LABT = (LAS float*)(hb + WK_LAB); LAS float* RHS = (LAS float*)(hb + WK_RHS);
    LAS float* WCa = (LAS float*)(hb + WK_WC); LAS bf16_t* SB = (LAS bf16_t*)(hb + WK_SB);
    LAS bf16_t* RDW = (LAS bf16_t*)(hb + WK_RAW1); LAS bf16_t* RK = RDW + 1024; LAS bf16_t* RR = RDW + 2048; LAS float* RIN = (LAS float*)(hb + WK_RAW1 + 6144);
    LAS bf16_t* RV = (LAS bf16_t*)(hb + WK_RAW2); LAS bf16_t* RA = RV + 1024;
    const int lt = lane >> 3, lc = lane & 7;
    for (int unit = F.bid; unit < 256; unit += F.G) {
        const int e = unit >> 7, b = (unit >> 3) & 15, j4 = unit & 7, cb = j4 * 256 + hh * 64, ch = cb + lane;
        const bf16_t* Qe = e ? +Q1 : +Q0; bf16_t* Ae = e ? +A1 : +A0;
        const float w0c = a.in[19][e * D + ch], a0c = a.in[22][e * D + ch], kkc = a.in[27][ch], kac = a.in[28][ch], omk = 1.f - kac;
        float kks[8];
        { const f32x4 q0 = *(const f32x4*)(a.in[27] + cb + 8 * lc), q1 = *(const f32x4*)(a.in[27] + cb + 8 * lc + 4); kks[0] = q0.x; kks[1] = q0.y; kks[2] = q0.z; kks[3] = q0.w; kks[4] = q1.x; kks[5] = q1.y; kks[6] = q1.z; kks[7] = q1.w; }
        __syncthreads();
        for (int i = F.tid; i < 4 * WK_HEAD / 16; i += NTHREADS) ((LAS u32x4*)F.lds)[i] = (u32x4){0u, 0u, 0u, 0u};
        f32x4 sacc[2][4];
#pragma unroll
        for (int i = 0; i < 2; ++i)
#pragma unroll
            for (int j = 0; j < 4; ++j) sacc[i][j] = (f32x4){0.f, 0.f, 0.f, 0.f};
        u32x4 g0[2], g1[2], g2[2];
#define WKV_ROW(ci_, tok_) ({ int L_, base_, s0_; if ((ci_) < 16) { L_ = CTXL; base_ = TL + b * CTXL; s0_ = (ci_) * 16; } else { L_ = SEQ; base_ = b * SEQ; s0_ = ((ci_) - 16) * 16; } \
            const int s_ = s0_ + (tok_); (size_t)(base_ + (e ? (L_ - 1 - s_) : s_)); })
#define WKV_LOAD(ci_) do { _Pragma("unroll") for (int j_ = 0; j_ < 2; ++j_) { const size_t off_ = WKV_ROW(ci_, lt + 8 * j_) * D + cb + 8 * lc; \
                if (role == 0) { g0[j_] = *(const u32x4*)(Qe + off_); g1[j_] = *(const u32x4*)(Kb + off_); g2[j_] = *(const u32x4*)(Rb + off_); } \
                else { g0[j_] = *(const u32x4*)(Vb + off_); g1[j_] = *(const u32x4*)(Ae + off_); } } } while (0)
#define WKV_STAGE() do { _Pragma("unroll") for (int j_ = 0; j_ < 2; ++j_) { const int o_ = (lt + 8 * j_) * 64 + 8 * lc; \
                if (role == 0) { float e_[8]; unpack8(g0[j_], e_); _Pragma("unroll") for (int x_ = 0; x_ < 8; ++x_) e_[x_] = __builtin_amdgcn_rcpf(fmaf(__builtin_amdgcn_exp2f(e_[x_]), 1.1428065003f, 1.1428065003f));     \
                    float k_[8]; unpack8(g1[j_], k_); f32x2_t s2_ = (f32x2_t){0.f, 0.f}; _Pragma("unroll") for (int x_ = 0; x_ < 4; ++x_) { const f32x2_t q_ = (f32x2_t){k_[2 * x_], k_[2 * x_ + 1]} * (f32x2_t){kks[2 * x_], kks[2 * x_ + 1]}; s2_ = __builtin_elementwise_fma(q_, q_, s2_); } \
                    float ss_ = s2_.x + s2_.y;     \
                    ss_ = row8_sum(ss_); if (lc == 0) RIN[lt + 8 * j_] = fminf(__builtin_amdgcn_rsqf(ss_), 1e12f);     \
                    *(LAS u32x4*)(RDW + o_) = pack8(e_); *(LAS u32x4*)(RK + o_) = g1[j_]; *(LAS u32x4*)(RR + o_) = g2[j_]; } \
                else { float a_[8]; unpack8(g1[j_], a_); _Pragma("unroll") for (int x_ = 0; x_ < 8; ++x_) a_[x_] = sigpre_(a_[x_]); \
                    *(LAS u32x4*)(RV + o_) = g0[j_]; *(LAS u32x4*)(RA + o_) = pack8(a_); } } } while (0)
        WKV_LOAD(0);
        __syncthreads();
        WKV_STAGE();
        __syncthreads();
        for (int ci = 0; ci < 144; ++ci) {
            if (ci + 1 < 144) WKV_LOAD(ci + 1);
            if (role == 0) {
                float cum = 0.f; unsigned vb[16], xdw[16], xk[16], xr[16]; float xin[16];
#pragma unroll
                for (int t = 0; t < 16; ++t) { xdw[t] = RDW[t * 64 + lane]; xk[t] = RK[t * 64 + lane]; xr[t] = RR[t * 64 + lane]; vb[t] = RV[t * 64 + lane]; }
#pragma unroll
                for (int q = 0; q < 4; ++q) { const f32x4 iv = *(const LAS f32x4*)(RIN + 4 * q); xin[4 * q] = iv.x; xin[4 * q + 1] = iv.y; xin[4 * q + 2] = iv.z; xin[4 * q + 3] = iv.w; }
                asm volatile("s_waitcnt lgkmcnt(0)" ::: "memory");
                float Wc = 1.f;
#pragma unroll
                for (int t = 0; t < 16; ++t) { const float wt = __builtin_amdgcn_exp2f(-bf2f(xdw[t])); const float Wprev = Wc; Wc *= wt;
                    const float kap = bf2f(xk[t]) * kkc * xin[t];
                    const unsigned pkd = pk2(-kap * Wprev, bf2f(xr[t]) * Wc);
                    AT[t * 72 + lane] = (bf16_t)(pkd & 0xffffu); RT[t * 72 + lane] = (bf16_t)(pkd >> 16); }
                cum = Wc;
                u32x4 v0, v1;
                v0.x = vb[0] | (vb[1] << 16); v0.y = vb[2] | (vb[3] << 16); v0.z = vb[4] | (vb[5] << 16); v0.w = vb[6] | (vb[7] << 16);
                v1.x = vb[8] | (vb[9] << 16); v1.y = vb[10] | (vb[11] << 16); v1.z = vb[12] | (vb[13] << 16); v1.w = vb[14] | (vb[15] << 16);
                *(LAS u32x4*)(PVT + lane * 40) = v0; *(LAS u32x4*)(PVT + lane * 40 + 8) = v1;
                WCa[lane] = cum;
            } else {
                float cum = 1.f; unsigned dlp[8], btp[8], xdw[16], xk[16], xa[16]; float xin[16];
#pragma unroll
                for (int t = 0; t < 16; ++t) { xdw[t] = RDW[t * 64 + lane]; xk[t] = RK[t * 64 + lane]; xa[t] = RA[t * 64 + lane]; }
#pragma unroll
                for (int q = 0; q < 4; ++q) { const f32x4 iv = *(const LAS f32x4*)(RIN + 4 * q); xin[4 * q] = iv.x; xin[4 * q + 1] = iv.y; xin[4 * q + 2] = iv.z; xin[4 * q + 3] = iv.w; }
                asm volatile("s_waitcnt lgkmcnt(0)" ::: "memory");
#pragma unroll
                for (int t2 = 0; t2 < 8; ++t2) { float dl[2], bt[2];
#pragma unroll
                    for (int q = 0; q < 2; ++q) { const int t = 2 * t2 + q; cum *= __builtin_amdgcn_exp2f(bf2f(xdw[t]));
                        const float av = bf2f(xa[t]); const float kc = bf2f(xk[t]) * cum;
                        bt[q] = kc * (kkc * xin[t]) * av; dl[q] = kc * fmaf(av, kac, omk); }
                    dlp[t2] = pk2(dl[0], dl[1]); btp[t2] = pk2(bt[0], bt[1]);
                    BD[(2 * t2) * 72 + lane] = (bf16_t)(dlp[t2] & 0xffffu); BD[(2 * t2 + 1) * 72 + lane] = (bf16_t)(dlp[t2] >> 16);
                    BD[(16 + 2 * t2) * 72 + lane] = (bf16_t)(btp[t2] & 0xffffu); BD[(17 + 2 * t2) * 72 + lane] = (bf16_t)(btp[t2] >> 16); }
                *(LAS u32x4*)(BDT + lane * 40) = (u32x4){dlp[0], dlp[1], dlp[2], dlp[3]}; *(LAS u32x4*)(BDT + lane * 40 + 8) = (u32x4){dlp[4], dlp[5], dlp[6], dlp[7]};
                *(LAS u32x4*)(BDT + lane * 40 + 16) = (u32x4){btp[0], btp[1], btp[2], btp[3]}; *(LAS u32x4*)(BDT + lane * 40 + 24) = (u32x4){btp[4], btp[5], btp[6], btp[7]};
            }
            __syncthreads();
            f32x4 ya[4];
            const f32x4 z4 = (f32x4){0.f, 0.f, 0.f, 0.f};
            if (role == 0) {
                const bf16x8 a0 = ldfrag(AT, 72, fr, fq, 0), a1 = ldfrag(AT, 72, fr, fq, 1);
                const bf16x8 bd00 = ldfrag(BD, 72, fr, fq, 0), bd01 = ldfrag(BD, 72, fr, fq, 1), bd10 = ldfrag(BD + 16 * 72, 72, fr, fq, 0), bd11 = ldfrag(BD + 16 * 72, 72, fr, fq, 1);
                bf16x8 sb[4][2], pv[4];
#pragma unroll
                for (int vt = 0; vt < 4; ++vt) { sb[vt][0] = ldfrag(SB + 16 * vt * 72, 72, fr, fq, 0); sb[vt][1] = ldfrag(SB + 16 * vt * 72, 72, fr, fq, 1); pv[vt] = ldfrag(PVT + 16 * vt * 40, 40, fr, fq, 0); }
                const f32x4 d0 = MFMA16(a1, bd01, MFMA16(a0, bd00, z4));
                const f32x4 d1 = MFMA16(a1, bd11, MFMA16(a0, bd10, z4));
#pragma unroll
                for (int vt = 0; vt < 4; ++vt) ya[vt] = MFMA16(a1, sb[vt][1], MFMA16(a0, sb[vt][0], z4));
#pragma unroll
                for (int r = 0; r < 4; ++r) { const int t = 4 * fq + r; const bool lo = fr < t;
                    LADM[t * 40 + fr] = (bf16_t)(pk2(lo ? d0[r] : 0.f, 0.f) & 0xffffu); LADM[t * 40 + 16 + fr] = (bf16_t)0; }
                {   f32x4 lv; lv.x = (fr < 4 * fq + 0) ? d1.x : 0.f; lv.y = (fr < 4 * fq + 1) ? d1.y : 0.f; lv.z = (fr < 4 * fq + 2) ? d1.z : 0.f; lv.w = (fr < 4 * fq + 3) ? d1.w : 0.f;
                    *(LAS f32x4*)(LABT + fr * 16 + 4 * fq) = lv; }
                asm volatile("s_waitcnt lgkmcnt(0)" ::: "memory");
                const bf16x8 lad = ldfrag(LADM, 40, fr, fq, 0);
#pragma unroll
                for (int vt = 0; vt < 4; ++vt) ya[vt] = MFMA16(lad, pv[vt], ya[vt]);
#pragma unroll
                for (int vt = 0; vt < 4; ++vt)
#pragma unroll
                    for (int r = 0; r < 4; ++r) RHS[(4 * fq + r) * 64 + 16 * vt + fr] = ya[vt][r];
            } else {
                const bf16x8 r0 = ldfrag(RT, 72, fr, fq, 0), r1 = ldfrag(RT, 72, fr, fq, 1);
                const bf16x8 bd00 = ldfrag(BD, 72, fr, fq, 0), bd01 = ldfrag(BD, 72, fr, fq, 1), bd10 = ldfrag(BD + 16 * 72, 72, fr, fq, 0), bd11 = ldfrag(BD + 16 * 72, 72, fr, fq, 1);
                bf16x8 sb[4][2];
#pragma unroll
                for (int vt = 0; vt < 4; ++vt) { sb[vt][0] = ldfrag(SB + 16 * vt * 72, 72, fr, fq, 0); sb[vt][1] = ldfrag(SB + 16 * vt * 72, 72, fr, fq, 1); }
                const f32x4 m0 = MFMA16(r1, bd01, MFMA16(r0, bd00, z4));
                const f32x4 m1 = MFMA16(r1, bd11, MFMA16(r0, bd10, z4));
#pragma unroll
                for (int vt = 0; vt < 4; ++vt) ya[vt] = MFMA16(sb[vt][1], r1, MFMA16(sb[vt][0], r0, z4));
#pragma unroll
                for (int r = 0; r < 4; ++r) { const int t = 4 * fq + r; const bool lo = fr <= t;
                    const unsigned pkd = pk2(lo ? m0[r] : 0.f, lo ? m1[r] : 0.f);
                    LM[t * 40 + fr] = (bf16_t)(pkd & 0xffffu); LM[t * 40 + 16 + fr] = (bf16_t)(pkd >> 16); }
            }
            asm volatile("s_waitcnt lgkmcnt(0)" ::: "memory");
            if (role == 0) {
                __builtin_amdgcn_s_setprio(3);
                f32x2_t ac[8];
#pragma unroll
                for (int t2 = 0; t2 < 8; ++t2) ac[t2] = (f32x2_t){RHS[(2 * t2) * 64 + lane], RHS[(2 * t2 + 1) * 64 + lane]};
#pragma unroll
                for (int i = 0; i < 15; ++i) { float col[16];
#pragma unroll
                    for (int q = 0; q < 4; ++q) if (4 * q + 3 > i) { const f32x4 lv = *(const LAS f32x4*)(LABT + i * 16 + 4 * q); col[4 * q] = lv.x; col[4 * q + 1] = lv.y; col[4 * q + 2] = lv.z; col[4 * q + 3] = lv.w; }
                    const float ai = (i & 1) ? ac[i >> 1].y : ac[i >> 1].x;
                    if (!(i & 1)) ac[i >> 1].y = fmaf(col[i + 1], ai, ac[i >> 1].y);
#pragma unroll
                    for (int t2 = 0; t2 < 8; ++t2) if (2 * t2 > i) ac[t2] = __builtin_elementwise_fma((f32x2_t){col[2 * t2], col[2 * t2 + 1]}, (f32x2_t){ai, ai}, ac[t2]); }
                *(LAS u32x4*)(PVT + lane * 40 + 16) = (u32x4){pk2(ac[0].x, ac[0].y), pk2(ac[1].x, ac[1].y), pk2(ac[2].x, ac[2].y), pk2(ac[3].x, ac[3].y)};
                *(LAS u32x4*)(PVT + lane * 40 + 24) = (u32x4){pk2(ac[4].x, ac[4].y), pk2(ac[5].x, ac[5].y), pk2(ac[6].x, ac[6].y), pk2(ac[7].x, ac[7].y)};
                __builtin_amdgcn_s_setprio(0);
            } else if (ci + 1 < 144) { WKV_STAGE(); }
            __syncthreads();
            if (role == 0 && ci + 1 < 144) WKV_STAGE();
            bf16x8 pvf[4];
#pragma unroll
            for (int vt = 0; vt < 4; ++vt) pvf[vt] = ldfrag(PVT + 16 * vt * 40, 40, fr, fq, 0);
            const bf16x8 bdf0 = ldfrag(BDT + 16 * (2 * role) * 40, 40, fr, fq, 0), bdf1 = ldfrag(BDT + 16 * (2 * role + 1) * 40, 40, fr, fq, 0);
            const f32x4 wcv0 = *(const LAS f32x4*)(WCa + 16 * (2 * role) + 4 * fq), wcv1 = *(const LAS f32x4*)(WCa + 16 * (2 * role + 1) + 4 * fq);
            if (role == 1) {
                const bf16x8 lmf = ldfrag(LM, 40, fr, fq, 0);
#pragma unroll
                for (int vt = 0; vt < 4; ++vt) ya[vt] = MFMA16(pvf[vt], lmf, ya[vt]);
            }
#pragma unroll
            for (int vt = 0; vt < 4; ++vt) { sacc[0][vt] = MFMA16(bdf0, pvf[vt], sacc[0][vt]); sacc[1][vt] = MFMA16(bdf1, pvf[vt], sacc[1][vt]); }
            if (role == 1) {
                if (ci >= 16) { const int s0 = (ci - 16) * 16;
                    const int sidx = s0 + fr; const size_t row = (size_t)(b * SEQ + (e ? (SEQ - 1 - sidx) : sidx));
#pragma unroll
                    for (int vt = 0; vt < 4; ++vt) { u32x2 o; o.x = pk2(ya[vt].x, ya[vt].y); o.y = pk2(ya[vt].z, ya[vt].w);
                        *(u32x2*)(Ae + row * D + cb + 16 * vt + 4 * fq) = o; } }
            }
#pragma unroll
            for (int i = 0; i < 2; ++i) { const int kt = 2 * role + i; const f32x4 wcv = i ? wcv1 : wcv0;
#pragma unroll
                for (int vt = 0; vt < 4; ++vt) { sacc[i][vt].x *= wcv.x; sacc[i][vt].y *= wcv.y; sacc[i][vt].z *= wcv.z; sacc[i][vt].w *= wcv.w;
                    u32x2 o; o.x = pk2(sacc[i][vt].x, sacc[i][vt].y); o.y = pk2(sacc[i][vt].z, sacc[i][vt].w);
                    *(LAS u32x2*)(SB + (16 * vt + fr) * 72 + 16 * kt + 4 * fq) = o; } }
            __syncthreads();
        }
#undef WKV_LOAD
#undef WKV_STAGE
#undef WKV_ROW
    }
}

__device__ __forceinline__ void phase_readout(Frame& F, const Args& a, const bf16_t* Y0, const bf16_t* Y1, const bf16_t* Rb, const bf16_t* Kb, const bf16_t* Vb, const bf16_t* Gb, bf16_t* O) {
    const int gw = F.bid * NWAVES + F.wave, NGW = F.G * NWAVES, RS = NGW >> 2;
    const int c = 8 * F.lane + 512 * (gw & 3);
    float rkv[8], lwv[8], lbv[8];
#pragma unroll
    for (int x = 0; x < 8; ++x) { rkv[x] = a.in[29][c + x]; lwv[x] = a.in[30][c + x]; lbv[x] = a.in[31][c + x]; }
    for (int r = gw >> 2; r < TL; r += 2 * RS) {
        u32x4 q[2][6];
#pragma unroll
        for (int u = 0; u < 2; ++u) { const int rr = r + u * RS; if (rr < TL) { const size_t off = (size_t)rr * D + c;
            q[u][0] = NTL((const u32x4*)(Y0 + off)); q[u][1] = NTL((const u32x4*)(Y1 + off)); q[u][2] = NTL((const u32x4*)(Rb + off));
            q[u][3] = NTL((const u32x4*)(Kb + off)); q[u][4] = NTL((const u32x4*)(Vb + off)); q[u][5] = NTL((const u32x4*)(Gb + off)); } }
#pragma unroll
        for (int u = 0; u < 2; ++u) { const int rr = r + u * RS; if (rr < TL) { const size_t off = (size_t)rr * D + c;
            float y0[8], y1[8], rr8[8], kk[8], vv[8], gg[8], y[8];
            unpack8(q[u][0], y0); unpack8(q[u][1], y1); unpack8(q[u][2], rr8); unpack8(q[u][3], kk); unpack8(q[u][4], vv); unpack8(q[u][5], gg);
            float s = 0.f, dt = 0.f;
#pragma unroll
            for (int x = 0; x < 8; ++x) { y[x] = y0[x] + y1[x]; s += y[x]; dt += rr8[x] * kk[x] * rkv[x]; }
            s = row8_sum(s); dt = row8_sum(dt);
            const float mean = s * (1.f / 64.f); float s2 = 0.f;
#pragma unroll
            for (int x = 0; x < 8; ++x) { y[x] -= mean; s2 += y[x] * y[x]; }
            s2 = row8_sum(s2);
            const float rstd = rsqrtf(s2 * (1.f / 64.f) + GN_EPS);
            float o[8];
#pragma unroll
            for (int x = 0; x < 8; ++x) o[x] = (y[x] * rstd * lwv[x] + lbv[x] + dt * vv[x]) * gg[x];
            u32x2 p; p.x = pk4_f8(o[0], o[1], o[2], o[3]); p.y = pk4_f8(o[4], o[5], o[6], o[7]); *(u32x2*)((unsigned char*)O + off) = p; } }
    }
}

__global__ void __launch_bounds__(NTHREADS, 2) fwd_kernel(Args args) {
    extern __shared__ __attribute__((aligned(16))) unsigned char lds_raw[];
    Frame F;
    F.lds = (LAS unsigned char*)lds_raw;
    F.tid = threadIdx.x; F.lane = F.tid & 63; F.wave = __builtin_amdgcn_readfirstlane(F.tid >> 6);
    F.G = gridDim.x; F.bid = blockIdx.x; F.ws = args.ws; F.out = args.out; F.ctl = (unsigned*)(args.ws + WS_CTL);
    volatile LAS unsigned* MISC = (volatile LAS unsigned*)(F.lds + LDS_MISC);
    if (F.tid < 64) MISC[F.tid] = 0u;
    __syncthreads();
    XcdBarrier bar = xcd_barrier_post(F.ctl + CW_BAR, MISC + 8);
    const int lo = args.ph_lo, hi = args.ph_hi;
#ifdef ONLY_PHASE
#define IN(k) ((k) == ONLY_PHASE)
#else
#define IN(k) (lo <= (k) && (k) < hi)
#endif
#define SEAM(k) do { if (IN(k) && IN((k) + 1)) xcd_barrier(bar); } while (0)
#ifndef DUPG
#define DUPG 0
#endif
#define REP(grp) if (((DUPG) >> (grp)) & 1)
    unsigned char* ws = args.ws;
    const float* MOD = (const float*)(ws + WS_MOD);
    LAS unsigned char* ring = F.lds;
    const LAS int* tstart = (const LAS int*)(F.lds + LDS_MISC + 256);

    if (IN(0)) { phase_prologue(F, args); REP(2) { __syncthreads(); phase_prologue(F, args); } }
    SEAM(0);
    if (IN(1)) { phase_modulate0(F, args); phase_router_build(F, args); }
    SEAM(1);
    if (IN(2)) {
        pg8::Gemm g{(const bf16_t*)(ws + WSLOT(0)), (const bf16_t*)(ws + WS_WIN), D / 2, D / 2, D / 2};
        PlainSched S{T / 256, NPROJ_PAD / 256, F.G, F.bid, (size_t)256 * D, (size_t)256 * D, 0, 0};
        EpiInProj E{(bf16_t*)(ws + WSLOT(1)), (bf16_t*)(ws + WSLOT(2)), (bf16_t*)(ws + WSLOT(1)) + (size_t)T * 1024, (float*)(ws + WS_DT), args.in[12]};
        pg8::gemm_phase<true>(ring, g, S, E);
        moe_convert_tail(F, args, (T / 256) * (NPROJ_PAD / 256), 0);
    }
    SEAM(2);
    if (IN(3)) {
        phase_conv(F, args); REP(3) { __syncthreads(); phase_conv(F, args); }
        __syncthreads();
        pg8::Gemm g{(const bf16_t*)(ws + WS_TW1), (const bf16_t*)(ws + WSLOT(1)) + (size_t)T * 1024, 256, 1024, 256};
        Four1Sched S{F.G, F.bid};
        EpiFour1 E{(bf16_t*)(ws + WSLOT(6)), (bf16_t*)(ws + WSLOT(6) + (size_t)64 * 512 * SEQ)};
        pg8::gemm_phase(ring, g, S, E); REP(0) { __syncthreads(); pg8::gemm_phase(ring, g, S, E); }
    }
    SEAM(3);
    if (IN(4)) {
        phase_ssd_chunked(F, args); REP(1) { __syncthreads(); phase_ssd_chunked(F, args); }
        __syncthreads();
        {   pg8::Gemm g{(const bf16_t*)(ws + WS_TW2L), (const bf16_t*)(ws + WSLOT(6)), 2048, 2048, 2048};
            Four2Sched S{F.G, F.bid, 8, (size_t)256 * 4096, (size_t)512 * SEQ};
            EpiFour2 E{(bf16_t*)(ws + WSLOT(5)), 0, SEQ};
            pg8::gemm_phase<true>(ring, g, S, E); }
        {   pg8::Gemm g{(const bf16_t*)(ws + WS_TW2C), (const bf16_t*)(ws + WSLOT(6) + (size_t)64 * 512 * SEQ), 256, 256, 256};
            Four2Sched S{F.G, F.bid, 1, (size_t)256 * 512, (size_t)512 * CTXL};
            EpiFour2 E{(bf16_t*)(ws + WSLOT(5)), TL, CTXL};
            pg8::gemm_phase<true>(ring, g, S, E); }
    }
    SEAM(4);
    if (IN(5)) { phase_ssd_out(F, args); REP(3) { __syncthreads(); phase_ssd_out(F, args); } }
    SEAM(5);
    if (IN(6)) {
        pg8::Gemm g{(const bf16_t*)(ws + WSLOT(5)), (const bf16_t*)(ws + WS_WOUT), D / 2, D / 2, D / 2};
        PlainSched S{T / 256, D / 256, F.G, F.bid, (size_t)256 * D, (size_t)256 * D, 0, 0};
        EpiResid<false> E{(bf16_t*)(ws + WSLOT(0)), args.in[0], args.in[2], nullptr, MOD + 2 * 2048};
        pg8::gemm_phase<true>(ring, g, S, E);
        moe_convert_tail(F, args, (T / 256) * (D / 256), cvt_tail_items((T / 256) * (NPROJ_PAD / 256), F.G));
    }
    SEAM(6);
    if (IN(7)) { phase_ln_mid(F, args, 0, T, (const bf16_t*)(ws + WSLOT(0)), (bf16_t*)(ws + WSLOT(2)), (bf16_t*)(ws + WSLOT(3)), ws + WSLOT(4)); REP(3) { __syncthreads(); phase_ln_mid(F, args, 0, T, (const bf16_t*)(ws + WSLOT(0)), (bf16_t*)(ws + WSLOT(2)), (bf16_t*)(ws + WSLOT(3)), ws + WSLOT(4)); } }
    SEAM(7);
    if (IN(8)) {
        pg8::Gemm g{(const bf16_t*)(ws + WSLOT(2)), (const bf16_t*)(ws + WS_ROUTB), D, D, D};
        RouterSched S{F.G, F.bid, T / 256, 0};
        EpiRouter E{(float*)(ws + WS_LOGIT), (const float*)(F.ctl + CW_RB)};
        pg8::gemm_phase(ring, g, S, E);
        __threadfence_block(); __syncthreads();
        for (int u = F.bid; u < T / 256; u += F.G) phase_route_count(F, args, u * 256, 256, T, F.ctl + CW_CNT0);
        if (F.bid >= T / 256) phase_route_count(F, args, 0, 0, T, F.ctl + CW_CNT0);
        __syncthreads();
        moe_convert_tail(F, args, T / 256, cvt_tail_items((T / 256) * (NPROJ_PAD / 256), F.G) + cvt_tail_items((T / 256) * (D / 256), F.G));
    }
    SEAM(8);
    if (IN(10)) { phase_route_scatter(F, T, F.ctl + CW_CNT0); __syncthreads(); moe_convert_rest(F, args, cvt_tail_items((T / 256) * (NPROJ_PAD / 256), F.G) + cvt_tail_items((T / 256) * (D / 256), F.G) + cvt_tail_items(T / 256, F.G)); }
    SEAM(10);
    if (IN(11)) {
        moe_tables(F, F.ctl + CW_CNT0);
        pg8::Gemm g{(const bf16_t*)(ws + WSLOT(4)), (const bf16_t*)(ws + WS_MOE), D / 2, D / 2, D / 2};
        MoeSched S{F.G, F.bid, 4, tstart, (size_t)256 * D, MOE_E_ELEMS, (size_t)256 * D};
        EpiMoe1 E{ws + WSLOT(0)};
        pg8::gemm_phase_gather<true>(ring, g, (const int*)(ws + WS_TOK), S, E);
    }
    SEAM(11);
    if (IN(12)) {
        moe_tables(F, F.ctl + CW_CNT0);
        pg8::Gemm g{(const bf16_t*)(ws + WSLOT(0)), (const bf16_t*)(ws + WS_MOE + (size_t)1024 * 2048), 256, 256, 256};
        MoeSched S{F.G, F.bid, 8, tstart, (size_t)256 * 512, MOE_E_ELEMS, (size_t)256 * 512};
        EpiF8Plain E{ws + WSLOT(4), D, F8_WINV};
        pg8::gemm_phase<true>(ring, g, S, E);
    }
    SEAM(12);
    if (IN(13)) { phase_ln_final<false>(F, args, 0, T, (const bf16_t*)(ws + WSLOT(2)), (const bf16_t*)(ws + WSLOT(4)), (bf16_t*)(ws + WSLOT(1)), (bf16_t*)(ws + WSLOT(3))); REP(3) { __syncthreads(); phase_ln_final<false>(F, args, 0, T, (const bf16_t*)(ws + WSLOT(2)), (const bf16_t*)(ws + WSLOT(4)), (bf16_t*)(ws + WSLOT(1)), (bf16_t*)(ws + WSLOT(3))); } }
    SEAM(13);
    if (IN(14)) { phase_mixes6(F, args, (const bf16_t*)(ws + WSLOT(1)), ws + WSLOT(4)); }
    SEAM(14);
    if (IN(15)) {
        pg8::Gemm g{(const bf16_t*)(ws + WSLOT(4)), (const bf16_t*)(ws + WS_BT1), D / 2, D / 2, D / 2};
        RkvSched S{F.G, F.bid, (size_t)256 * D, (size_t)256 * D, SLOT};
        EpiRKV E{(bf16_t*)(ws + WSLOT(0)), (long)(2 * SLOT / 2), (long)((bf16_t*)F.out - (bf16_t*)(ws + WSLOT(0)))};
        pg8::gemm_phase<true>(ring, g, S, E);
    }
    if (IN(17)) {
        pg8::Gemm g{(const bf16_t*)(ws + WSLOT(4) + (size_t)T * D), (const bf16_t*)(ws + WS_BT1 + (size_t)6144 * D), D / 2, D / 2, D / 2};
        PlainSched S{T / 256, 3, F.G, F.bid, (size_t)256 * D, (size_t)256 * D, 1, SLOT};
        EpiLora1 E{(bf16_t*)(ws + WS_TW), (bf16_t*)(ws + WS_TA), (bf16_t*)(ws + WS_TG)};
        pg8::gemm_phase<true>(ring, g, S, E);
    }
    SEAM(17);
    if (IN(18)) {
        {   pg8::Gemm g{(const bf16_t*)(ws + WS_TW), (const bf16_t*)(ws + WS_BT2W), 128, 128, 128};
            PlainSched S{T / 256, 16, F.G, F.bid, (size_t)256 * 256, (size_t)256 * 256, 0, 0};
            EpiSigGrp E{(bf16_t*)(ws + WSLOT(3)), (bf16_t*)(ws + WSLOT(4)), args.in[19]};
            pg8::gemm_phase<true>(ring, g, S, E); }
        {   pg8::Gemm g{(const bf16_t*)(ws + WS_TA), (const bf16_t*)(ws + WS_BT2A), 128, 128, 128};
            PlainSched S{T / 256, 16, F.G, F.bid, (size_t)256 * 256, (size_t)256 * 256, 0, 0};
            EpiSigGrp E{(bf16_t*)(ws + WSLOT(5)), (bf16_t*)(ws + WSLOT(6)), args.in[22]};
            pg8::gemm_phase<true>(ring, g, S, E); }
        {   pg8::Gemm g{(const bf16_t*)(ws + WS_TG), (const bf16_t*)(ws + WS_G2T), 128, 128, 128};
            PlainSched S{TL / 256, 8, F.G, F.bid, (size_t)256 * 256, (size_t)256 * 256, 0, 0};
            EpiBf16Plain E{(bf16_t*)(ws + WS_MOE), D, F8_WINV};
            pg8::gemm_phase<true>(ring, g, S, E); }
    }
    SEAM(18);
    if (IN(19)) {
        phase_wkv_chunked(F, args, (const bf16_t*)(ws + WSLOT(0)), (const bf16_t*)(ws + WSLOT(2)), (const bf16_t*)F.out, (const bf16_t*)(ws + WSLOT(3)), (const bf16_t*)(ws + WSLOT(4)),
                       (bf16_t*)(ws + WSLOT(5)), (bf16_t*)(ws + WSLOT(6)));
    }
    SEAM(19);
    if (IN(20)) {
        phase_readout(F, args, (const bf16_t*)(ws + WSLOT(5)), (const bf16_t*)(ws + WSLOT(6)), (const bf16_t*)(ws + WSLOT(0)), (const bf16_t*)(ws + WSLOT(2)), (const bf16_t*)F.out,
                      (const bf16_t*)(ws + WS_MOE), (bf16_t*)(ws + WSLOT(3)));
        REP(3) phase_readout(F, args, (const bf16_t*)(ws + WSLOT(5)), (const bf16_t*)(ws + WSLOT(6)), (const bf16_t*)(ws + WSLOT(0)), (const bf16_t*)(ws + WSLOT(2)), (const bf16_t*)F.out,
                      (const bf16_t*)(ws + WS_MOE), (bf16_t*)(ws + WSLOT(3)));
    }
    SEAM(20);
    if (IN(21)) {
        pg8::Gemm g{(const bf16_t*)(ws + WSLOT(3)), (const bf16_t*)(ws + WS_WOT), D / 2, D / 2, D / 2};
        PlainSched S{TL / 256, D / 256, F.G, F.bid, (size_t)256 * D, (size_t)256 * D, 0, 0};
        EpiResid<true> E{(bf16_t*)(ws + WSLOT(4)), nullptr, nullptr, (const bf16_t*)(ws + WSLOT(1)), MOD + (size_t)17 * 12288 + 2 * 2048};
        pg8::gemm_phase<true>(ring, g, S, E);
    }
    SEAM(21);
    if (IN(22)) {
        phase_ln_mid(F, args, 1, TL, (const bf16_t*)(ws + WSLOT(4)), (bf16_t*)(ws + WSLOT(0)), (bf16_t*)(ws + WSLOT(2)), ws + WSLOT(1)); REP(3) { __syncthreads(); phase_ln_mid(F, args, 1, TL, (const bf16_t*)(ws + WSLOT(4)), (bf16_t*)(ws + WSLOT(0)), (bf16_t*)(ws + WSLOT(2)), ws + WSLOT(1)); }
        LAS float* scr = (LAS float*)(F.lds + F.wave * 8704);
        const int gw = F.bid * NWAVES + F.wave, NGW = F.G * NWAVES;
        const size_t lo1 = (size_t)NE * 2048 * 512;
        for (int it = gw; it < 32 * 1536; it += NGW) moe_convert_item(args.in[34] + lo1, args.in[35] + lo1, args.in[36] + lo1, (bf16_t*)(ws + WS_MOE), it, scr, F.lane);
        REP(2) for (int it = gw; it < 32 * 1536; it += NGW) moe_convert_item(args.in[34] + lo1, args.in[35] + lo1, args.in[36] + lo1, (bf16_t*)(ws + WS_MOE), it, scr, F.lane);
    }
    SEAM(22);
    if (IN(23)) {
        pg8::Gemm g{(const bf16_t*)(ws + WSLOT(0)), (const bf16_t*)(ws + WS_ROUTB), D, D, D};
        RouterSched S{F.G, F.bid, TL / 256, 544};
        EpiRouter E{(float*)(ws + WS_LOGIT), (const float*)(F.ctl + CW_RB) + 17 * 32};
        pg8::gemm_phase(ring, g, S, E);
        __threadfence_block(); __syncthreads();
        for (int u = F.bid; u < TL / 256; u += F.G) phase_route_count(F, args, u * 256, 256, TL, F.ctl + CW_CNT1);
        if (F.bid >= TL / 256) phase_route_count(F, args, 0, 0, TL, F.ctl + CW_CNT1);
    }
    SEAM(23);
    if (IN(25)) { phase_route_scatter(F, TL, F.ctl + CW_CNT1); }
    SEAM(25);
    if (IN(26)) {
        moe_tables(F, F.ctl + CW_CNT1);
        pg8::Gemm g{(const bf16_t*)(ws + WSLOT(1)), (const bf16_t*)(ws + WS_MOE), D / 2, D / 2, D / 2};
        MoeSched S{F.G, F.bid, 4, tstart, (size_t)256 * D, MOE_E_ELEMS, (size_t)256 * D};
        EpiMoe1 E{ws + WSLOT(6)};
        pg8::gemm_phase_gather<true>(ring, g, (const int*)(ws + WS_TOK), S, E);
    }
    SEAM(26);
    if (IN(27)) {
        moe_tables(F, F.ctl + CW_CNT1);
        pg8::Gemm g{(const bf16_t*)(ws + WSLOT(6)), (const bf16_t*)(ws + WS_MOE + (size_t)1024 * 2048), 256, 256, 256};
        MoeSched S{F.G, F.bid, 8, tstart, (size_t)256 * 512, MOE_E_ELEMS, (size_t)256 * 512};
        EpiF8Plain E{ws + WSLOT(3), D, F8_WINV};
        pg8::gemm_phase<true>(ring, g, S, E);
    }
    SEAM(27);
    if (IN(28)) { phase_ln_final<true>(F, args, 1, TL, (const bf16_t*)(ws + WSLOT(0)), (const bf16_t*)(ws + WSLOT(3)), nullptr, nullptr); REP(3) { __syncthreads(); phase_ln_final<true>(F, args, 1, TL, (const bf16_t*)(ws + WSLOT(0)), (const bf16_t*)(ws + WSLOT(3)), nullptr, nullptr); } }
#undef IN
#undef SEAM
}

constexpr int N_PHASES = 29;

extern "C" void kernel_launch(void* const* d_in, const int* in_sizes, int n_in, void* d_out, int out_size, void* d_ws, size_t ws_size, hipStream_t stream) {
    static int grid = 0;
    if (grid == 0) {
        if (n_in != 37 || out_size != TL * D || ws_size < WS_END) {
            fprintf(stderr, "kernel_launch: built for 37 inputs, out of %d floats, >= %zu bytes of workspace; got n_in %d, out %d, ws %zu; nothing launched\n", TL * D, (size_t)WS_END, n_in, out_size, ws_size);
            grid = -1; return; }
        int dev = 0, cus = 0, per_cu = 0;
        if (hipGetDevice(&dev) != hipSuccess || hipDeviceGetAttribute(&cus, hipDeviceAttributeMultiprocessorCount, dev) != hipSuccess) { fprintf(stderr, "kernel_launch: device query failed\n"); grid = -1; return; }
        if (hipFuncSetAttribute((const void*)fwd_kernel, hipFuncAttributeMaxDynamicSharedMemorySize, LDS_BYTES) != hipSuccess) { fprintf(stderr, "kernel_launch: hipFuncSetAttribute failed\n"); grid = -1; return; }
        if (hipOccupancyMaxActiveBlocksPerMultiprocessor(&per_cu, (const void*)fwd_kernel, NTHREADS, LDS_BYTES) != hipSuccess || per_cu < 1) {
            fprintf(stderr, "kernel_launch: occupancy query reports %d workgroups per CU; nothing launched\n", per_cu); (void)hipGetLastError(); grid = -1; return; }
        (void)hipGetLastError();
        grid = cus;
    }
    if (grid < 0) return;
    if (hipMemsetAsync((char*)d_ws + WS_CTL, 0, CTL_BYTES, stream) != hipSuccess) { fprintf(stderr, "kernel_launch: memset failed\n"); return; }
    Args a{};
    for (int i = 0; i < 37; ++i) a.in[i] = (const float*)d_in[i];
    a.out = (float*)d_out; a.ws = (unsigned char*)d_ws;
#ifndef MK_PER_PHASE
    a.ph_lo = 0; a.ph_hi = N_PHASES;
    hipLaunchKernelGGL(fwd_kernel, dim3(grid), dim3(NTHREADS), LDS_BYTES, stream, a);
#else
    for (int p = 0; p < N_PHASES; ++p) { a.ph_lo = p; a.ph_hi = p + 1; hipLaunchKernelGGL(fwd_kernel, dim3(grid), dim3(NTHREADS), LDS_BYTES, stream, a); }
#endif
    const hipError_t le = hipPeekAtLastError();
    if (le != hipSuccess) fprintf(stderr, "kernel_launch: launch failed: %s\n", hipGetErrorName(le));
}
```
